# Optimizing an MI355X kernel written in HIP

```python
import math
import jax, jax.numpy as jnp
from jax import lax
import numpy as np

D_MODEL = 1024
BATCH = 2
SEQ = 8192
DEPTH = 4

N_MIXERS = 2
N_HEADS = 16
HEAD_DIM = D_MODEL // N_HEADS
BLOCK_Q = 128
POOL_WINDOWS = (2, 4, 8, 16)
N_POOL_GROUPS = len(POOL_WINDOWS)
POOL_GROUP = D_MODEL // N_POOL_GROUPS
D_FF = 2816
PLE_DIM = 256
EPS = 1e-6

kernel_name = "hybrid_stickbreak_pool_macaron"


def rms_norm(x, g):
    xf = x.astype(jnp.float32)
    y = xf * lax.rsqrt(jnp.mean(xf * xf, axis=-1, keepdims=True) + EPS)
    return (y * g.astype(jnp.float32)).astype(x.dtype)


def swiglu(h, w_gu, w_down):
    gate, up = jnp.split(h @ w_gu, 2, axis=-1)
    return (jax.nn.silu(gate) * up) @ w_down


def stick_breaking_attention(h, w_qkv, q_gain, k_gain, w_o):
    B, S, _ = h.shape
    q, k, v = jnp.split(h @ w_qkv, 3, axis=-1)
    q = rms_norm(q.reshape(B, S, N_HEADS, HEAD_DIM), q_gain)
    k = rms_norm(k.reshape(B, S, N_HEADS, HEAD_DIM), k_gain)
    v = v.reshape(B, S, N_HEADS, HEAD_DIM)
    q, k, v = (t.transpose(0, 2, 1, 3) for t in (q, k, v))
    scale = 1.0 / math.sqrt(HEAD_DIM)
    outs = []
    for blk in range(S // BLOCK_Q):
        t0 = blk * BLOCK_Q
        t1 = t0 + BLOCK_Q
        qb = q[:, :, t0:t1]
        kb = k[:, :, :t1]
        vb = v[:, :, :t1]
        z = jnp.einsum('bhqd,bhkd->bhqk', qb, kb).astype(jnp.float32) * scale
        qpos = t0 + jnp.arange(BLOCK_Q)
        kpos = jnp.arange(t1)
        causal = kpos[None, :] < qpos[:, None]
        log_stay = jnp.where(causal, jax.nn.log_sigmoid(-z), 0.0)
        log_after = lax.cumsum(log_stay, axis=3, reverse=True) - log_stay
        weights = jnp.where(causal, jnp.exp(jax.nn.log_sigmoid(z) + log_after), 0.0)
        outs.append(jnp.einsum('bhqk,bhkd->bhqd', weights.astype(vb.dtype), vb))
    o = jnp.concatenate(outs, axis=2)
    o = o.transpose(0, 2, 1, 3).reshape(B, S, D_MODEL)
    return o @ w_o


def multiscale_pool_mixer(h, w_in, w_grp, scale):
    B, S, _ = h.shape
    u = (h @ w_in).reshape(B, S, N_POOL_GROUPS, POOL_GROUP)
    uf = u.astype(jnp.float32)
    c = jnp.cumsum(uf, axis=1)
    pos = jnp.arange(S)
    outs = []
    for gi, w in enumerate(POOL_WINDOWS):
        cg = c[:, :, gi]
        cpad = jnp.pad(cg, ((0, 0), (w, 0), (0, 0)))
        wsum = cpad[:, w:] - cpad[:, :S]
        cnt = jnp.minimum(pos + 1, w).astype(jnp.float32)
        outs.append(wsum / cnt[None, :, None] - uf[:, :, gi])
    pooled = jnp.stack(outs, axis=2).astype(h.dtype)
    y = jnp.einsum('bsgc,gcd->bsgd', pooled, w_grp).reshape(B, S, D_MODEL)
    return y * scale


def setup_inputs(seed: int = 0) -> dict:
    key = jax.random.key(seed)
    ks = iter(jax.random.split(key, 32))
    n_a = (DEPTH + 1) // 2
    n_b = DEPTH // 2
    f32 = jnp.float32

    def w(shape, fan_in):
        return jax.random.normal(next(ks), shape, f32) * fan_in ** -0.5

    def gain(shape):
        return 1.0 + 0.05 * jax.random.normal(next(ks), shape, f32)

    return {
        "x": jax.random.normal(next(ks), (BATCH, SEQ, D_MODEL), f32),
        "p": jax.random.normal(next(ks), (DEPTH, BATCH, SEQ, PLE_DIM), f32),
        "norm_ffn1": gain((DEPTH, D_MODEL)),
        "w_ffn1_gu": w((DEPTH, D_MODEL, 2 * D_FF), D_MODEL),
        "w_ffn1_down": w((DEPTH, D_FF, D_MODEL), D_FF),
        "norm_mix": gain((DEPTH, D_MODEL)),
        "w_qkv": w((n_a, D_MODEL, 3 * D_MODEL), D_MODEL),
        "q_norm": gain((n_a, HEAD_DIM)),
        "k_norm": gain((n_a, HEAD_DIM)),
        "w_o": w((n_a, D_MODEL, D_MODEL), D_MODEL),
        "w_pool_in": w((n_b, D_MODEL, D_MODEL), D_MODEL),
        "w_pool_grp": w((n_b, N_POOL_GROUPS, POOL_GROUP, POOL_GROUP), POOL_GROUP),
        "pool_scale": gain((n_b, D_MODEL)),
        "norm_ffn2": gain((DEPTH, D_MODEL)),
        "w_ffn2_gu": w((DEPTH, D_MODEL, 2 * D_FF), D_MODEL),
        "w_ffn2_down": w((DEPTH, D_FF, D_MODEL), D_FF),
        "norm_ple": gain((DEPTH, D_MODEL)),
        "w_ple_gate": w((DEPTH, D_MODEL, D_MODEL), D_MODEL),
        "w_ple_proj": w((DEPTH, PLE_DIM, D_MODEL), PLE_DIM),
    }


def reference(x, p, norm_ffn1, w_ffn1_gu, w_ffn1_down, norm_mix, w_qkv, q_norm,
              k_norm, w_o, w_pool_in, w_pool_grp, pool_scale, norm_ffn2,
              w_ffn2_gu, w_ffn2_down, norm_ple, w_ple_gate, w_ple_proj):
    for i in range(DEPTH):
        x = x + 0.5 * swiglu(rms_norm(x, norm_ffn1[i]), w_ffn1_gu[i], w_ffn1_down[i])
        h = rms_norm(x, norm_mix[i])
        j = i // N_MIXERS
        if i % N_MIXERS == 0:
            mix = stick_breaking_attention(h, w_qkv[j], q_norm[j], k_norm[j], w_o[j])
        else:
            mix = multiscale_pool_mixer(h, w_pool_in[j], w_pool_grp[j], pool_scale[j])
        x = x + mix
        x = x + 0.5 * swiglu(rms_norm(x, norm_ffn2[i]), w_ffn2_gu[i], w_ffn2_down[i])
        gate = jax.nn.sigmoid(rms_norm(x, norm_ple[i]) @ w_ple_gate[i])
        x = x + gate * (p[i] @ w_ple_proj[i])
    return x
```

```cpp
#include <hip/hip_runtime.h>
#include <hip/hip_cooperative_groups.h>
#include <cstdio>
#include <cstdint>
namespace cg = cooperative_groups;

#define LAS __attribute__((address_space(3)))
typedef unsigned short bf16_t;
typedef short bf16x8 __attribute__((ext_vector_type(8)));
typedef short s16x4 __attribute__((ext_vector_type(4)));
typedef float f32x4 __attribute__((ext_vector_type(4)));
typedef unsigned u32x4 __attribute__((ext_vector_type(4)));
typedef unsigned u32x2 __attribute__((ext_vector_type(2)));

#ifndef DBG_MASK
#define DBG_MASK 1023
#endif
#ifndef MK_N_LAUNCHES
#define MK_N_LAUNCHES 1
#endif

constexpr int D = 1024, M = 16384, SEQ = 8192, DEPTH = 4, NH = 16, HD = 64, DFF = 2816, PLE = 256;
constexpr float EPS = 1e-6f;
constexpr int NPHASE = 1 + 8 * DEPTH;

constexpr size_t SZ_SS = (size_t)17 * M * 4;
constexpr size_t SZ_WGU = (size_t)2 * DFF * D * 2, SZ_WDN = (size_t)D * DFF * 2, SZ_WQKV = (size_t)3 * D * D * 2, SZ_WDD = (size_t)D * D * 2, SZ_WGRP = (size_t)4 * 256 * 256 * 2, SZ_WPROJ = (size_t)D * PLE * 2;
constexpr size_t WS_SS = 0;
constexpr size_t WS_WGU = 2u << 20;
constexpr size_t WS_WDN = WS_WGU + 8 * SZ_WGU;
constexpr size_t WS_WQKV = WS_WDN + 8 * SZ_WDN;
constexpr size_t WS_WO = WS_WQKV + 2 * SZ_WQKV;
constexpr size_t WS_WIN = WS_WO + 2 * SZ_WDD;
constexpr size_t WS_WGRP = WS_WIN + 2 * SZ_WDD;
constexpr size_t WS_WGATE = WS_WGRP + 2 * SZ_WGRP;
constexpr size_t WS_WPROJ = WS_WGATE + 4 * SZ_WDD;
constexpr size_t WS_XB = WS_WPROJ + 4 * SZ_WPROJ;
constexpr size_t SZ_MD = (size_t)M * D * 2;
constexpr size_t WS_R1 = WS_XB + SZ_MD;
constexpr size_t WS_PB = WS_R1 + 4 * SZ_MD;
constexpr size_t WS_PE = WS_PB + SZ_MD;
constexpr size_t WS_END = WS_PE + SZ_MD;
static_assert(SZ_SS <= WS_WGU && (size_t)M * DFF * 2 <= 4 * SZ_MD, "ws map");

constexpr int LDS_BYTES = 131072 + 1024;

namespace pg8 {
constexpr int BM = 256, BK = 64, HALF = 128, HTB = HALF * BK * 2, STAGE_BYTES = 8 * HTB, NXCD = 8, WGM = 8;
__host__ __device__ __forceinline__ int lds_byte(int r, int c) { const int st = (r >> 4) * 2 + (c >> 5), rr = r & 15, cc = c & 31, ob = rr * 64 + cc * 2; return st * 1024 + (ob ^ (((ob >> 9) & 1) << 5)); }
__host__ __device__ __forceinline__ void stage_rc(int b, int& R, int& C) { const int st = b / 1024, sb = b % 1024, swz = sb ^ (((sb >> 9) & 1) << 5); R = (st >> 1) * 16 + swz / 64; C = (st & 1) * 32 + (swz % 64) / 2; }
__host__ __device__ __forceinline__ int perm32(int rho) { const int n = rho >> 4, i = rho & 15; return 8 * (i >> 2) + 4 * n + (i & 3); }

struct Unit { int pm, pn; };
struct Gemm { const bf16_t* A; const bf16_t* Bt; int lda, ldb, K; int a_pn_off; };

struct StaticOrder {
    int nM, nN, nwg, G, c;
    __device__ void init(int M_, int N_, int G_, int c_) { nM = M_ / BM; nN = N_ / BM; nwg = nM * nN; G = G_; c = c_; }
    __device__ bool next(int i, Unit& u) const {
        const long L = (long)i * G + c; if (L >= nwg) return false;
        int wgid = (int)L; { const int q = nwg / NXCD, r = nwg % NXCD, xcd = wgid % NXCD, off = wgid / NXCD; wgid = (xcd < r ? xcd * (q + 1) : r * (q + 1) + (xcd - r) * q) + off; }
        const int nig = WGM * nN, gid = wgid / nig, fm = gid * WGM, gsz = (nM - fm) < WGM ? (nM - fm) : WGM;
        u.pm = fm + ((wgid % nig) % gsz); u.pn = (wgid % nig) / gsz; return true;
    }
};

__device__ __forceinline__ unsigned cvt_pk_bf16(float lo, float hi) { unsigned r; asm volatile("v_cvt_pk_bf16_f32 %0, %1, %2" : "=v"(r) : "v"(lo), "v"(hi)); return r; }
__device__ __forceinline__ u32x4 pack8(const f32x4 a, const f32x4 b) { u32x4 w; w.x = cvt_pk_bf16(a[0], a[1]); w.y = cvt_pk_bf16(a[2], a[3]); w.z = cvt_pk_bf16(b[0], b[1]); w.w = cvt_pk_bf16(b[2], b[3]); return w; }
__device__ __forceinline__ float bf_lo(unsigned w) { return __uint_as_float(w << 16); }
__device__ __forceinline__ float bf_hi(unsigned w) { return __uint_as_float(w & 0xffff0000u); }
__device__ __forceinline__ float fast_sigmoid(float v) { return __builtin_amdgcn_rcpf(1.0f + __expf(-v)); }

typedef f32x4 Acc[2][2][4][2];

struct EpiGU {
    const float* ss; bf16_t* act;
    __device__ __forceinline__ void operator()(const Acc& acc, const Unit& u, int wr, int wc, int fr, int fq) const {
        const int row0 = u.pm * BM + wr * 64 + fr, col = u.pn * 128 + wc * 32 + 8 * fq;
#pragma unroll
        for (int ai = 0; ai < 2; ++ai)
#pragma unroll
            for (int m = 0; m < 4; ++m) {
                const int row = row0 + ai * HALF + m * 16;
                const float rinv = rsqrtf(ss[row] * (1.0f / D) + EPS);
                f32x4 o[2];
#pragma unroll
                for (int n = 0; n < 2; ++n) {
                    const f32x4 g = acc[ai][0][m][n] * rinv, up = acc[ai][1][m][n] * rinv;
#pragma unroll
                    for (int e = 0; e < 4; ++e) o[n][e] = g[e] * fast_sigmoid(g[e]) * up[e];
                }
                *(u32x4*)(act + (size_t)row * DFF + col) = pack8(o[0], o[1]);
            }
    }
};
template <int MODE> struct EpiRes {
    float* X; bf16_t* XB; float* ss_next; float alpha; const float* colscale; const float* ss_cur; const bf16_t* pe;
    __device__ __forceinline__ void operator()(const Acc& acc, const Unit& u, int wr, int wc, int fr, int fq) const {
        const int row0 = u.pm * BM + wr * 64 + fr, colb = u.pn * BM + wc * 32 + 8 * fq;
#pragma unroll
        for (int ai = 0; ai < 2; ++ai)
#pragma unroll
            for (int m = 0; m < 4; ++m) {
                const int row = row0 + ai * HALF + m * 16;
                float rinv = 1.f; if (MODE == 2) rinv = rsqrtf(ss_cur[row] * (1.0f / D) + EPS);
                float s2 = 0.f;
#pragma unroll
                for (int bj = 0; bj < 2; ++bj) {
                    const int col = colb + bj * HALF; const size_t off = (size_t)row * D + col;
                    f32x4 x0 = *(const f32x4*)(X + off), x1 = *(const f32x4*)(X + off + 4);
                    f32x4 v0 = acc[ai][bj][m][0], v1 = acc[ai][bj][m][1];
                    if (MODE == 0) { v0 = v0 * alpha; v1 = v1 * alpha; }
                    if (MODE == 1) { v0 = v0 * *(const f32x4*)(colscale + col); v1 = v1 * *(const f32x4*)(colscale + col + 4); }
                    if (MODE == 2) {
                        const u32x4 pw = *(const u32x4*)(pe + off);
                        const f32x4 p0 = {bf_lo(pw.x), bf_hi(pw.x), bf_lo(pw.y), bf_hi(pw.y)}, p1 = {bf_lo(pw.z), bf_hi(pw.z), bf_lo(pw.w), bf_hi(pw.w)};
#pragma unroll
                        for (int e = 0; e < 4; ++e) { v0[e] = fast_sigmoid(v0[e] * rinv) * p0[e]; v1[e] = fast_sigmoid(v1[e] * rinv) * p1[e]; }
                    }
                    x0 = x0 + v0; x1 = x1 + v1;
                    *(f32x4*)(X + off) = x0; *(f32x4*)(X + off + 4) = x1;
                    *(u32x4*)(XB + off) = pack8(x0, x1);
                    s2 += (x0[0] * x0[0] + x0[1] * x0[1]) + (x0[2] * x0[2] + x0[3] * x0[3]) + (x1[0] * x1[0] + x1[1] * x1[1]) + (x1[2] * x1[2] + x1[3] * x1[3]);
                }
                s2 += __shfl_xor(s2, 16); s2 += __shfl_xor(s2, 32);
                if (fq == 0) unsafeAtomicAdd(ss_next + row, s2);
                asm volatile("" ::: "memory");
            }
    }
};
struct EpiQKV {
    const float* ss; bf16_t* Q; const float* qg; const float* kg;
    __device__ __forceinline__ void operator()(const Acc& acc, const Unit& u, int wr, int wc, int fr, int fq) const {
        const int which = u.pn >> 2, pnl = u.pn & 3;
        bf16_t* dst = Q + (size_t)which * M * D;
        const int row0 = u.pm * BM + wr * 64 + fr, colb = pnl * 256 + wc * 64 + 8 * fq;
        const float* gp = which == 0 ? qg : kg;
        f32x4 gn[2][2];
#pragma unroll
        for (int bj = 0; bj < 2; ++bj)
#pragma unroll
            for (int n = 0; n < 2; ++n) gn[bj][n] = *(const f32x4*)(gp + 32 * bj + 8 * fq + 4 * n);
        const float qs = which == 0 ? 0.125f : 1.0f;
#pragma unroll
        for (int ai = 0; ai < 2; ++ai)
#pragma unroll
            for (int m = 0; m < 4; ++m) {
                const int row = row0 + ai * HALF + m * 16;
                const float rinv = rsqrtf(ss[row] * (1.0f / D) + EPS);
                f32x4 v[2][2]; float s2 = 0.f;
#pragma unroll
                for (int bj = 0; bj < 2; ++bj)
#pragma unroll
                    for (int n = 0; n < 2; ++n) { v[bj][n] = acc[ai][bj][m][n] * rinv; const f32x4 t = v[bj][n]; s2 += (t[0] * t[0] + t[1] * t[1]) + (t[2] * t[2] + t[3] * t[3]); }
                s2 += __shfl_xor(s2, 16); s2 += __shfl_xor(s2, 32);
                if (which < 2) {
                    const float hr = rsqrtf(s2 * (1.0f / HD) + EPS) * qs;
#pragma unroll
                    for (int bj = 0; bj < 2; ++bj)
#pragma unroll
                        for (int n = 0; n < 2; ++n) v[bj][n] = v[bj][n] * hr * gn[bj][n];
                }
#pragma unroll
                for (int bj = 0; bj < 2; ++bj) *(u32x4*)(dst + (size_t)row * D + colb + 32 * bj) = pack8(v[bj][0], v[bj][1]);
            }
    }
};
template <bool RINV> struct EpiBf16S {
    const float* ss; bf16_t* O; int ldc;
    __device__ __forceinline__ void operator()(const Acc& acc, const Unit& u, int wr, int wc, int fr, int fq) const {
        const int row0 = u.pm * BM + wr * 64 + fr, colb = u.pn * BM + wc * 32 + 8 * fq;
#pragma unroll
        for (int ai = 0; ai < 2; ++ai)
#pragma unroll
            for (int m = 0; m < 4; ++m) {
                const int row = row0 + ai * HALF + m * 16;
                float rinv = 1.f; if (RINV) rinv = rsqrtf(ss[row] * (1.0f / D) + EPS);
#pragma unroll
                for (int bj = 0; bj < 2; ++bj) *(u32x4*)(O + (size_t)row * ldc + colb + bj * HALF) = pack8(acc[ai][bj][m][0] * rinv, acc[ai][bj][m][1] * rinv);
            }
    }
};

template <class Epi, bool ALIGN_EPI>
__device__ __forceinline__ void gemm_phase(LAS unsigned char* lds, const Gemm g, const StaticOrder& S, const Epi& E) {
    int tid_ = threadIdx.x; asm volatile("" : "+v"(tid_));
    const int tid = tid_, wid = __builtin_amdgcn_readfirstlane(tid >> 6), lane = tid & 63, wr = wid >> 2, wc = wid & 3, fr = lane & 15, fq = lane >> 4;
    const int K = g.K, nt = K / BK;
    unsigned voffA[2], voffB[2];
#pragma unroll
    for (int i = 0; i < 2; ++i) { int R, C; stage_rc(tid * 16 + i * 8192, R, C); const int Rb = (R & ~31) + perm32(R & 31);
        voffA[i] = (unsigned)(R * g.lda + C) * 2u; voffB[i] = (unsigned)(Rb * g.ldb + C) * 2u; }
    const size_t kstep = (size_t)(BK * 2);
    const size_t hstepA = (size_t)HALF * g.lda * 2, hstepB = (size_t)HALF * g.ldb * 2;
    const size_t tstepA = 2 * hstepA, tstepB = 2 * hstepB;
    const unsigned ldsw = (unsigned)wid * 1024u;
    const int aoff = lds_byte(wr * 64 + fr, fq * 8), boff = lds_byte(wc * 32 + fr, fq * 8);
#define PG8_SA(b, h) (((b) * 2 + (h)) * HTB)
#define PG8_SB(b, h) ((4 + (b) * 2 + (h)) * HTB)
#define PG8_STAGE(bufoff, gbase, voff) do { _Pragma("unroll") for (int _i = 0; _i < 2; ++_i) \
        __builtin_amdgcn_global_load_lds((const unsigned*)((const char*)(gbase) + (voff)[_i]), (LAS unsigned*)(lds + (bufoff) + ldsw + _i * 8192), 16, 0, 0); } while (0)
#define PG8_LDA(dst, b, h) do { _Pragma("unroll") for (int m = 0; m < 4; ++m) _Pragma("unroll") for (int k = 0; k < 2; ++k) dst[m][k] = *(const LAS bf16x8*)(lds + PG8_SA(b, h) + aoff + m * 2048 + k * 1024); } while (0)
#define PG8_LDB(dst, b, h) do { _Pragma("unroll") for (int n = 0; n < 2; ++n) _Pragma("unroll") for (int k = 0; k < 2; ++k) dst[n][k] = *(const LAS bf16x8*)(lds + PG8_SB(b, h) + boff + n * 2048 + k * 1024); } while (0)
#define PG8_MMA(ai, bj, At, Bt) do { __builtin_amdgcn_s_setprio(1); _Pragma("unroll") for (int m = 0; m < 4; ++m) _Pragma("unroll") for (int n = 0; n < 2; ++n) _Pragma("unroll") for (int k = 0; k < 2; ++k) \
        acc[ai][bj][m][n] = __builtin_amdgcn_mfma_f32_16x16x32_bf16(Bt[n][k], At[m][k], acc[ai][bj][m][n], 0, 0, 0); __builtin_amdgcn_s_setprio(0); } while (0)
#define PG8_WAIT_V(n) asm volatile("s_waitcnt vmcnt(" #n ")" ::: "memory")
#define PG8_WAIT_L(n) asm volatile("s_waitcnt lgkmcnt(" #n ")" ::: "memory")
#define PG8_BAR __builtin_amdgcn_s_barrier()
#define PG8_SCHED __builtin_amdgcn_sched_barrier(0)
    Unit cur, nxt; int ui = 0;
    if (!S.next(0, cur)) return;
    Acc acc;
#pragma unroll
    for (int a = 0; a < 2; ++a)
#pragma unroll
        for (int b = 0; b < 2; ++b)
#pragma unroll
            for (int m = 0; m < 4; ++m)
#pragma unroll
                for (int n = 0; n < 2; ++n) acc[a][b][m][n] = (f32x4){0.f, 0.f, 0.f, 0.f};
    bf16x8 At[4][2], B0[2][2], B1[2][2];
    const char* cA = (const char*)g.A + (size_t)cur.pm * tstepA + (size_t)cur.pn * g.a_pn_off * 2; const char* cB = (const char*)g.Bt + (size_t)cur.pn * tstepB;
    PG8_STAGE(PG8_SB(0, 0), cB, voffB); PG8_STAGE(PG8_SB(0, 1), cB + hstepB, voffB); PG8_STAGE(PG8_SA(0, 0), cA, voffA); PG8_STAGE(PG8_SA(0, 1), cA + hstepA, voffA);
    if (wr == 1) PG8_BAR;
    PG8_WAIT_V(2); PG8_BAR;
    PG8_STAGE(PG8_SB(1, 0), cB + kstep, voffB); PG8_STAGE(PG8_SA(1, 0), cA + kstep, voffA); PG8_STAGE(PG8_SB(1, 1), cB + hstepB + kstep, voffB);
    PG8_WAIT_V(6); PG8_BAR;
    for (;;) {
        const bool has_next = S.next(ui + 1, nxt);
        const char* nA = has_next ? (const char*)g.A + (size_t)nxt.pm * tstepA + (size_t)nxt.pn * g.a_pn_off * 2 : cA; const char* nB = has_next ? (const char*)g.Bt + (size_t)nxt.pn * tstepB : cB;
        for (int t = 0; t < nt; t += 2) {
            const bool last = (t == nt - 2);
            const char* a1 = cA + (size_t)(t + 1) * kstep;
            const char* a2 = last ? nA : cA + (size_t)(t + 2) * kstep; const char* b2 = last ? nB : cB + (size_t)(t + 2) * kstep;
            const char* a3 = a2 + kstep; const char* b3 = b2 + kstep;
            PG8_LDB(B0, 0, 0); PG8_LDB(B1, 0, 1); PG8_SCHED; PG8_LDA(At, 0, 0); PG8_STAGE(PG8_SA(1, 1), a1 + hstepA, voffA);
            PG8_WAIT_V(8); PG8_WAIT_L(0); PG8_BAR; PG8_MMA(0, 0, At, B0); PG8_MMA(0, 1, At, B1); PG8_BAR; PG8_SCHED;
            PG8_LDA(At, 0, 1); PG8_STAGE(PG8_SB(0, 0), b2, voffB); PG8_STAGE(PG8_SB(0, 1), b2 + hstepB, voffB); PG8_STAGE(PG8_SA(0, 0), a2, voffA);
            PG8_WAIT_V(8); PG8_WAIT_L(0); PG8_BAR; PG8_MMA(1, 0, At, B0); PG8_MMA(1, 1, At, B1); PG8_BAR; PG8_SCHED;
            PG8_LDB(B0, 1, 0); PG8_LDB(B1, 1, 1); PG8_SCHED; PG8_LDA(At, 1, 0); PG8_STAGE(PG8_SA(0, 1), a2 + hstepA, voffA);
            PG8_WAIT_V(8); PG8_WAIT_L(0); PG8_BAR; PG8_MMA(0, 0, At, B0); PG8_MMA(0, 1, At, B1); PG8_BAR; PG8_SCHED;
            PG8_LDA(At, 1, 1); PG8_STAGE(PG8_SB(1, 0), b3, voffB); PG8_STAGE(PG8_SB(1, 1), b3 + hstepB, voffB); PG8_STAGE(PG8_SA(1, 0), a3, voffA);
            PG8_WAIT_V(8); PG8_WAIT_L(0); PG8_BAR; PG8_MMA(1, 0, At, B0); PG8_MMA(1, 1, At, B1); PG8_BAR; PG8_SCHED;
        }
        if constexpr (ALIGN_EPI) { if (wr == 0) PG8_BAR; }
        E(acc, cur, wr, wc, fr, fq);
        if (!has_next) break;
#pragma unroll
        for (int a = 0; a < 2; ++a)
#pragma unroll
            for (int b = 0; b < 2; ++b)
#pragma unroll
                for (int m = 0; m < 4; ++m)
#pragma unroll
                    for (int n = 0; n < 2; ++n) acc[a][b][m][n] = (f32x4){0.f, 0.f, 0.f, 0.f};
        cur = nxt; cA = nA; cB = nB; ++ui;
        if constexpr (ALIGN_EPI) { if (wr == 1) PG8_BAR; }
    }
    PG8_WAIT_V(0);
    if constexpr (!ALIGN_EPI) { if (wr == 0) PG8_BAR; }
    PG8_BAR;
#undef PG8_SA
#undef PG8_SB
#undef PG8_STAGE
#undef PG8_LDA
#undef PG8_LDB
#undef PG8_MMA
#undef PG8_WAIT_V
#undef PG8_WAIT_L
#undef PG8_BAR
#undef PG8_SCHED
}
}

__device__ __forceinline__ unsigned f2bf(float f) { unsigned u = __builtin_bit_cast(unsigned, f); return (u + 0x7fffu + ((u >> 16) & 1u)) >> 16; }
__device__ __forceinline__ unsigned pk2(float lo, float hi) { return f2bf(lo) | (f2bf(hi) << 16); }
__device__ __forceinline__ float wave_sum(float v) {
#pragma unroll
    for (int o = 1; o < 64; o <<= 1) v += __shfl_xor(v, o);
    return v;
}
template <int MAP> __device__ __forceinline__ int map_row(int n0) {
    if (MAP == 1) { const int up = n0 >= DFF ? 1 : 0, j = n0 - up * DFF; return 256 * (j >> 7) + 128 * up + (j & 127); }
    if (MAP == 2) { const int pn = n0 >> 8, r = n0 & 255, wc = r >> 6, bj = (r >> 5) & 1; return 256 * pn + 128 * bj + 32 * wc; }
    return n0;
}
template <int MAP> __device__ __forceinline__ void conv_item(const float* W, int K, int N, bf16_t* WT, const float* gain, LAS float* scr, int item, int lane) {
    const int nblk = N / 32, kb = item / nblk, nb = item % nblk, k0 = 64 * kb, n0 = 32 * nb;
#pragma unroll 8
    for (int i = 0; i < 32; ++i) { const int kk = 2 * i + (lane >> 5); float w = W[(size_t)(k0 + kk) * N + n0 + (lane & 31)]; if (gain) w *= gain[k0 + kk]; scr[kk * 33 + (lane & 31)] = w; }
    asm volatile("s_waitcnt lgkmcnt(0)" ::: "memory");
    const int c = lane & 7; const int r0 = map_row<MAP>(n0);
#pragma unroll
    for (int j = 0; j < 4; ++j) { const int n = (lane >> 3) + 8 * j; const LAS float* s = scr + (8 * c) * 33 + n;
        u32x4 o; o.x = pk2(s[0 * 33], s[1 * 33]); o.y = pk2(s[2 * 33], s[3 * 33]); o.z = pk2(s[4 * 33], s[5 * 33]); o.w = pk2(s[6 * 33], s[7 * 33]);
        *(u32x4*)(WT + (size_t)(r0 + n) * K + k0 + 8 * c) = o; }
    asm volatile("s_waitcnt lgkmcnt(0)" ::: "memory");
}

struct Args { const float* in[19]; float* out; unsigned char* ws; int ph_lo, ph_hi; };

template <int MAP> __device__ __forceinline__ void conv_mat(const float* W, int K, int N, bf16_t* WT, const float* gain, LAS float* scr, int gw, int NGW, int& off, int lane) {
    const int nitems = (K / 64) * (N / 32);
    int start = gw - off; if (start < 0) start += NGW;
    for (int it = start; it < nitems; it += NGW) conv_item<MAP>(W, K, N, WT, gain, scr, it, lane);
    off = (off + nitems) % NGW;
}

__device__ __forceinline__ void prologue(const Args& a, LAS unsigned char* lds, int G) {
    const int tid = threadIdx.x, lane = tid & 63, wave = tid >> 6;
    const int gw = blockIdx.x * 8 + wave, NGW = G * 8;
    unsigned char* ws = a.ws;
    { float* ss = (float*)(ws + WS_SS) + M; const int n4 = 16 * M / 4;
      for (int i = blockIdx.x * 512 + tid; i < n4; i += G * 512) ((f32x4*)ss)[i] = (f32x4){0.f, 0.f, 0.f, 0.f}; }
    { float* ss0 = (float*)(ws + WS_SS); bf16_t* xb = (bf16_t*)(ws + WS_XB);
      for (int m = gw; m < M; m += NGW) {
          const f32x4* xr = (const f32x4*)(a.in[0] + (size_t)m * D) + lane; f32x4* orow = (f32x4*)(a.out + (size_t)m * D) + lane;
          u32x2* brow = (u32x2*)(xb + (size_t)m * D) + lane; float s = 0.f;
#pragma unroll
          for (int j = 0; j < 4; ++j) { const f32x4 v = xr[64 * j]; orow[64 * j] = v; u32x2 w; w.x = pk2(v[0], v[1]); w.y = pk2(v[2], v[3]); brow[64 * j] = w; s += (v[0] * v[0] + v[1] * v[1]) + (v[2] * v[2] + v[3] * v[3]); }
          s = wave_sum(s); if (lane == 0) ss0[m] = s;
      } }
    { const f32x4* p4 = (const f32x4*)a.in[1]; u32x4* pb = (u32x4*)(ws + WS_PB); const int n8 = DEPTH * M * PLE / 8;
      for (int i = blockIdx.x * 512 + tid; i < n8; i += G * 512) { const f32x4 v0 = p4[2 * i], v1 = p4[2 * i + 1]; u32x4 w; w.x = pk2(v0[0], v0[1]); w.y = pk2(v0[2], v0[3]); w.z = pk2(v1[0], v1[1]); w.w = pk2(v1[2], v1[3]); pb[i] = w; } }
    LAS float* scr = (LAS float*)(lds + wave * 8704);
    int off = 0;
#pragma unroll 1
    for (int l = 0; l < DEPTH; ++l) {
        conv_mat<1>(a.in[3] + (size_t)l * D * 2 * DFF, D, 2 * DFF, (bf16_t*)(ws + WS_WGU + (size_t)(2 * l) * SZ_WGU), a.in[2] + l * D, scr, gw, NGW, off, lane);
        conv_mat<1>(a.in[14] + (size_t)l * D * 2 * DFF, D, 2 * DFF, (bf16_t*)(ws + WS_WGU + (size_t)(2 * l + 1) * SZ_WGU), a.in[13] + l * D, scr, gw, NGW, off, lane);
        conv_mat<0>(a.in[4] + (size_t)l * DFF * D, DFF, D, (bf16_t*)(ws + WS_WDN + (size_t)(2 * l) * SZ_WDN), nullptr, scr, gw, NGW, off, lane);
        conv_mat<0>(a.in[15] + (size_t)l * DFF * D, DFF, D, (bf16_t*)(ws + WS_WDN + (size_t)(2 * l + 1) * SZ_WDN), nullptr, scr, gw, NGW, off, lane);
        conv_mat<0>(a.in[17] + (size_t)l * D * D, D, D, (bf16_t*)(ws + WS_WGATE + (size_t)l * SZ_WDD), a.in[16] + l * D, scr, gw, NGW, off, lane);
        conv_mat<0>(a.in[18] + (size_t)l * PLE * D, PLE, D, (bf16_t*)(ws + WS_WPROJ + (size_t)l * SZ_WPROJ), nullptr, scr, gw, NGW, off, lane);
    }
#pragma unroll 1
    for (int j = 0; j < 2; ++j) {
        conv_mat<2>(a.in[6] + (size_t)j * D * 3 * D, D, 3 * D, (bf16_t*)(ws + WS_WQKV + (size_t)j * SZ_WQKV), a.in[5] + (2 * j) * D, scr, gw, NGW, off, lane);
        conv_mat<0>(a.in[9] + (size_t)j * D * D, D, D, (bf16_t*)(ws + WS_WO + (size_t)j * SZ_WDD), nullptr, scr, gw, NGW, off, lane);
        conv_mat<0>(a.in[10] + (size_t)j * D * D, D, D, (bf16_t*)(ws + WS_WIN + (size_t)j * SZ_WDD), a.in[5] + (2 * j + 1) * D, scr, gw, NGW, off, lane);
#pragma unroll 1
        for (int g = 0; g < 4; ++g)
            conv_mat<0>(a.in[11] + (size_t)(j * 4 + g) * 256 * 256, 256, 256, (bf16_t*)(ws + WS_WGRP + (size_t)j * SZ_WGRP + (size_t)g * 256 * 256 * 2), nullptr, scr, gw, NGW, off, lane);
    }
}

__device__ __forceinline__ void unpack8(const u32x4 w, float* f) {
    f[0] = pg8::bf_lo(w.x); f[1] = pg8::bf_hi(w.x); f[2] = pg8::bf_lo(w.y); f[3] = pg8::bf_hi(w.y); f[4] = pg8::bf_lo(w.z); f[5] = pg8::bf_hi(w.z); f[6] = pg8::bf_lo(w.w); f[7] = pg8::bf_hi(w.w);
}
__device__ __forceinline__ void pool_phase(const bf16_t* U, bf16_t* P, int G) {
    int tid_ = threadIdx.x; asm volatile("" : "+v"(tid_));
    for (int item = blockIdx.x * 512 + tid_; item < (M / 16) * 128; item += G * 512) {
        const int chunk = item & 127, strip = item >> 7, row0 = strip * 16, t0 = row0 & (SEQ - 1);
        const int w = 2 << (chunk >> 5);
        const bf16_t* up = U + (size_t)row0 * D + chunk * 8; bf16_t* pp = P + (size_t)row0 * D + chunk * 8;
        float S[8];
#pragma unroll
        for (int e = 0; e < 8; ++e) S[e] = 0.f;
        for (int j = 1; j < w; ++j) if (t0 - j >= 0) { float f[8]; unpack8(*(const u32x4*)(up - (ptrdiff_t)j * D), f);
#pragma unroll
            for (int e = 0; e < 8; ++e) S[e] += f[e]; }
#pragma unroll 4
        for (int r = 0; r < 16; ++r) {
            const int t = t0 + r; float cur[8]; unpack8(*(const u32x4*)(up + (ptrdiff_t)r * D), cur);
            const float ic = 1.0f / (float)(t + 1 < w ? t + 1 : w); float o[8];
#pragma unroll
            for (int e = 0; e < 8; ++e) { S[e] += cur[e]; o[e] = S[e] * ic - cur[e]; }
            u32x4 ow; ow.x = pk2(o[0], o[1]); ow.y = pk2(o[2], o[3]); ow.z = pk2(o[4], o[5]); ow.w = pk2(o[6], o[7]);
            *(u32x4*)(pp + (ptrdiff_t)r * D) = ow;
            if (t - w + 1 >= 0) { float f[8]; unpack8(*(const u32x4*)(up + (ptrdiff_t)(r - w + 1) * D), f);
#pragma unroll
                for (int e = 0; e < 8; ++e) S[e] -= f[e]; }
        }
    }
}

__device__ __forceinline__ void attn_phase(LAS unsigned char* lds, const bf16_t* Q, const bf16_t* Kg, const bf16_t* Vg, bf16_t* O, int G) {
    LAS bf16_t* Ks = (LAS bf16_t*)lds;
    LAS bf16_t* Vt = (LAS bf16_t*)(lds + 9216);
    LAS unsigned* flags = (LAS unsigned*)(lds + 9216 + 8704);
    int tid_ = threadIdx.x; asm volatile("" : "+v"(tid_));
    const int tid = tid_, wid = tid >> 6, lane = tid & 63, l16 = lane & 15, g = lane >> 4;
    for (int unit = blockIdx.x; unit < 2 * NH * (SEQ / 128); unit += G) {
        const int qblk = unit & 63, bh = unit >> 6, b = bh >> 4, h = bh & 15;
        const size_t rowbase = (size_t)b * SEQ; const int t0 = qblk * 128 + wid * 16, tq = t0 + l16;
        bf16x8 qf[2];
        { const bf16_t* qp = Q + (rowbase + tq) * D + h * HD + 8 * g; qf[0] = *(const bf16x8*)qp; qf[1] = *(const bf16x8*)(qp + 32); }
        f32x4 o[4];
#pragma unroll
        for (int i = 0; i < 4; ++i) o[i] = (f32x4){0.f, 0.f, 0.f, 0.f};
        float carry = 0.f; unsigned wave_done = 0u;
        for (int kt = 2 * qblk + 1; kt >= 0; --kt) {
            if (lane == 0) flags[wid] = wave_done;
            __syncthreads();
            unsigned all = 1u;
#pragma unroll
            for (int i = 0; i < 8; ++i) all &= flags[i];
            if (all) break;
            { const int key = tid >> 3, dc = tid & 7; const size_t src = (rowbase + (size_t)kt * 64 + key) * D + h * HD + 8 * dc;
              const u32x4 kv = *(const u32x4*)(Kg + src); const u32x4 vv = *(const u32x4*)(Vg + src);
              *(LAS u32x4*)(Ks + key * 72 + 8 * dc) = kv;
              LAS bf16_t* vd = Vt + (8 * dc) * 68 + key;
              vd[0 * 68] = (bf16_t)(vv.x & 0xffffu); vd[1 * 68] = (bf16_t)(vv.x >> 16); vd[2 * 68] = (bf16_t)(vv.y & 0xffffu); vd[3 * 68] = (bf16_t)(vv.y >> 16);
              vd[4 * 68] = (bf16_t)(vv.z & 0xffffu); vd[5 * 68] = (bf16_t)(vv.z >> 16); vd[6 * 68] = (bf16_t)(vv.w & 0xffffu); vd[7 * 68] = (bf16_t)(vv.w >> 16); }
            __syncthreads();
            if (kt * 64 <= t0 + 14) {
                f32x4 z[4];
#pragma unroll
                for (int bb = 0; bb < 4; ++bb) { z[bb] = (f32x4){0.f, 0.f, 0.f, 0.f};
#pragma unroll
                    for (int ks = 0; ks < 2; ++ks) { const bf16x8 ka = *(const LAS bf16x8*)(Ks + (16 * bb + l16) * 72 + 32 * ks + 8 * g); z[bb] = __builtin_amdgcn_mfma_f32_16x16x32_bf16(ka, qf[ks], z[bb], 0, 0, 0); } }
                float sp[4][4], tot[4], Ex[4];
#pragma unroll
                for (int bb = 0; bb < 4; ++bb) {
                    float T = 0.f;
#pragma unroll
                    for (int i = 0; i < 4; ++i) { const int s = kt * 64 + 16 * bb + 4 * g + i; const float zz = z[bb][i];
                        const float v = fmaxf(zz, 0.f) + __logf(1.0f + __expf(-fabsf(zz))); sp[bb][i] = (s < tq) ? v : 0.f; T += sp[bb][i]; }
                    const float a_ = __shfl_xor(T, 16), b2 = T + a_, c_ = __shfl_xor(b2, 32);
                    tot[bb] = b2 + c_; Ex[bb] = ((g & 1) == 0 ? a_ : 0.f) + ((g & 2) == 0 ? c_ : 0.f);
                }
                float wv[4][4]; float right = 0.f;
#pragma unroll
                for (int bb = 3; bb >= 0; --bb) {
                    const float base = carry - right - Ex[bb]; float run = 0.f;
#pragma unroll
                    for (int i = 3; i >= 0; --i) { const int s = kt * 64 + 16 * bb + 4 * g + i; run += sp[bb][i]; const float F = base - run; wv[bb][i] = (s < tq) ? __expf(z[bb][i] + F) : 0.f; }
                    right += tot[bb];
                }
                carry -= right;
#pragma unroll
                for (int c = 0; c < 2; ++c) {
                    u32x4 pw; pw.x = pg8::cvt_pk_bf16(wv[2 * c][0], wv[2 * c][1]); pw.y = pg8::cvt_pk_bf16(wv[2 * c][2], wv[2 * c][3]);
                    pw.z = pg8::cvt_pk_bf16(wv[2 * c + 1][0], wv[2 * c + 1][1]); pw.w = pg8::cvt_pk_bf16(wv[2 * c + 1][2], wv[2 * c + 1][3]);
                    const bf16x8 pbf = __builtin_bit_cast(bf16x8, pw);
#pragma unroll
                    for (int db = 0; db < 4; ++db) {
                        const LAS bf16_t* vp = Vt + (16 * db + l16) * 68 + 32 * c + 4 * g;
                        const u32x2 v0 = *(const LAS u32x2*)vp, v1 = *(const LAS u32x2*)(vp + 16);
                        u32x4 va; va.x = v0.x; va.y = v0.y; va.z = v1.x; va.w = v1.y;
                        o[db] = __builtin_amdgcn_mfma_f32_16x16x32_bf16(__builtin_bit_cast(bf16x8, va), pbf, o[db], 0, 0, 0);
                    }
                }
                wave_done = __all(carry < -105.0f) ? 1u : 0u;
            }
        }
        __syncthreads();
        { bf16_t* op = O + (rowbase + tq) * D + h * HD + 4 * g;
#pragma unroll
          for (int db = 0; db < 4; ++db) { u32x2 w; w.x = pg8::cvt_pk_bf16(o[db][0], o[db][1]); w.y = pg8::cvt_pk_bf16(o[db][2], o[db][3]); *(u32x2*)(op + 16 * db) = w; } }
    }
}

__global__ void __launch_bounds__(512, 2) fwd_kernel(Args a) {
    extern __shared__ __attribute__((aligned(16))) unsigned char lds_raw[];
    LAS unsigned char* lds = (LAS unsigned char*)lds_raw;
    const int G = gridDim.x;
    unsigned char* ws = a.ws;
    float* SS = (float*)(ws + WS_SS); float* X = a.out;
    bf16_t* XB = (bf16_t*)(ws + WS_XB); bf16_t* R1 = (bf16_t*)(ws + WS_R1); bf16_t* PE = (bf16_t*)(ws + WS_PE);
    bf16_t* ACT = R1; bf16_t* Qb = R1; bf16_t* Kb = R1 + (size_t)M * D; bf16_t* Vb = R1 + (size_t)2 * M * D; bf16_t* Ob = R1 + (size_t)3 * M * D;
    bf16_t* Ub = R1; bf16_t* PLb = R1 + (size_t)M * D;
#if MK_N_LAUNCHES == 1
#define IN(k) true
#define SEAM(k) cg::this_grid().sync()
#else
    const int lo = a.ph_lo, hi = a.ph_hi;
#define IN(k) (lo <= (k) && (k) < hi)
#define SEAM(k) do { if (lo < (k) && (k) < hi) cg::this_grid().sync(); } while (0)
#endif
    if (IN(0)) { if (DBG_MASK & 1) prologue(a, lds, G); }
#pragma unroll 1
    for (int l = 0; l < DEPTH; ++l) {
        const int j = l >> 1, p0 = 1 + 8 * l; const bool is_attn = (l & 1) == 0;
        pg8::StaticOrder S;
#pragma unroll 1
        for (int f = 0; f < 2; ++f) {
            const int pa = p0 + 5 * f;
            SEAM(pa);
            if ((DBG_MASK & 2) && IN(pa)) {
                pg8::Gemm g{XB, (const bf16_t*)(ws + WS_WGU + (size_t)(2 * l + f) * SZ_WGU), D, D, D, 0}; S.init(M, 2 * DFF, G, blockIdx.x);
                pg8::EpiGU E{SS + (size_t)(4 * l + 2 * f) * M, ACT};
                pg8::gemm_phase<pg8::EpiGU, true>(lds, g, S, E);
            }
            SEAM(pa + 1);
            if ((DBG_MASK & 4) && IN(pa + 1)) {
                pg8::Gemm g{ACT, (const bf16_t*)(ws + WS_WDN + (size_t)(2 * l + f) * SZ_WDN), DFF, DFF, DFF, 0}; S.init(M, D, G, blockIdx.x);
                pg8::EpiRes<0> E{X, XB, SS + (size_t)(4 * l + 2 * f + 1) * M, 0.5f, nullptr, nullptr, nullptr};
                pg8::gemm_phase<pg8::EpiRes<0>, false>(lds, g, S, E);
            }
            if (f == 0) {
                SEAM(p0 + 2);
                if (IN(p0 + 2)) {
                    if (is_attn) { if (DBG_MASK & 8) {
                        pg8::Gemm g{XB, (const bf16_t*)(ws + WS_WQKV + (size_t)j * SZ_WQKV), D, D, D, 0}; S.init(M, 3 * D, G, blockIdx.x);
                        pg8::EpiQKV E{SS + (size_t)(4 * l + 1) * M, Qb, a.in[7] + j * HD, a.in[8] + j * HD};
                        pg8::gemm_phase<pg8::EpiQKV, true>(lds, g, S, E);
                    } } else if (DBG_MASK & 16) {
                        pg8::Gemm g{XB, (const bf16_t*)(ws + WS_WIN + (size_t)j * SZ_WDD), D, D, D, 0}; S.init(M, D, G, blockIdx.x);
                        pg8::EpiBf16S<true> E{SS + (size_t)(4 * l + 1) * M, Ub, D};
                        pg8::gemm_phase<pg8::EpiBf16S<true>, false>(lds, g, S, E);
                    }
                }
                SEAM(p0 + 3);
                if (IN(p0 + 3)) {
                    if (is_attn) { if (DBG_MASK & 32) attn_phase(lds, Qb, Kb, Vb, Ob, G); }
                    else if (DBG_MASK & 64) pool_phase(Ub, PLb, G);
                }
                SEAM(p0 + 4);
                if (IN(p0 + 4)) {
                    if (is_attn) { if (DBG_MASK & 128) {
                        pg8::Gemm g{Ob, (const bf16_t*)(ws + WS_WO + (size_t)j * SZ_WDD), D, D, D, 0}; S.init(M, D, G, blockIdx.x);
                        pg8::EpiRes<0> E{X, XB, SS + (size_t)(4 * l + 2) * M, 1.0f, nullptr, nullptr, nullptr};
                        pg8::gemm_phase<pg8::EpiRes<0>, false>(lds, g, S, E);
                    } } else if (DBG_MASK & 256) {
                        pg8::Gemm g{PLb, (const bf16_t*)(ws + WS_WGRP + (size_t)j * SZ_WGRP), D, 256, 256, 256}; S.init(M, D, G, blockIdx.x);
                        pg8::EpiRes<1> E{X, XB, SS + (size_t)(4 * l + 2) * M, 1.0f, a.in[12] + j * D, nullptr, nullptr};
                        pg8::gemm_phase<pg8::EpiRes<1>, false>(lds, g, S, E);
                    }
                }
            }
        }
        SEAM(p0 + 7);
        if ((DBG_MASK & 512) && IN(p0 + 7)) {
            { pg8::Gemm g{(const bf16_t*)(ws + WS_PB) + (size_t)l * M * PLE, (const bf16_t*)(ws + WS_WPROJ + (size_t)l * SZ_WPROJ), PLE, PLE, PLE, 0}; S.init(M, D, G, blockIdx.x);
              pg8::EpiBf16S<false> E{nullptr, PE, D};
              pg8::gemm_phase<pg8::EpiBf16S<false>, false>(lds, g, S, E); }
            { pg8::Gemm g{XB, (const bf16_t*)(ws + WS_WGATE + (size_t)l * SZ_WDD), D, D, D, 0}; S.init(M, D, G, blockIdx.x);
              pg8::EpiRes<2> E{X, XB, SS + (size_t)(4 * l + 4) * M, 1.0f, nullptr, SS + (size_t)(4 * l + 3) * M, PE};
              pg8::gemm_phase<pg8::EpiRes<2>, false>(lds, g, S, E); }
        }
    }
#undef IN
#undef SEAM
}

extern "C" void kernel_launch(void* const* d_in, const int* in_sizes, int n_in, void* d_out, int out_size, void* d_ws, size_t ws_size, hipStream_t stream) {
    static int grid = 0;
    if (grid == 0) {
        if (n_in != 19 || out_size != M * D || ws_size < WS_END) { fprintf(stderr, "kernel_launch: unexpected shapes (n_in %d, out %d, ws %zu, need %zu)\n", n_in, out_size, ws_size, (size_t)WS_END); grid = -1; return; }
        int dev = 0, cus = 0, per_cu = 0;
        hipGetDevice(&dev); hipDeviceGetAttribute(&cus, hipDeviceAttributeMultiprocessorCount, dev);
        if (hipFuncSetAttribute((const void*)fwd_kernel, hipFuncAttributeMaxDynamicSharedMemorySize, LDS_BYTES) != hipSuccess) { fprintf(stderr, "kernel_launch: hipFuncSetAttribute failed\n"); }
        if (hipOccupancyMaxActiveBlocksPerMultiprocessor(&per_cu, (const void*)fwd_kernel, 512, LDS_BYTES) != hipSuccess || per_cu < 1) per_cu = 1;
        (void)hipGetLastError();
        grid = cus * per_cu;
        fprintf(stderr, "kernel_launch: grid %d (cus %d x %d)\n", grid, cus, per_cu);
    }
    if (grid < 0) return;
    Args a{};
    for (int i = 0; i < 19; ++i) a.in[i] = (const float*)d_in[i];
    a.out = (float*)d_out; a.ws = (unsigned char*)d_ws;
#if MK_N_LAUNCHES == 1
    a.ph_lo = 0; a.ph_hi = NPHASE;
    void* args[] = {&a};
    hipError_t e = hipLaunchCooperativeKernel((const void*)fwd_kernel, dim3(grid), dim3(512), args, LDS_BYTES, stream);
    if (e != hipSuccess) fprintf(stderr, "cooperative launch failed: %s (grid %d)\n", hipGetErrorString(e), grid);
#else
    for (int ph = 0; ph < NPHASE; ++ph) { a.ph_lo = ph; a.ph_hi = ph + 1; hipLaunchKernelGGL(fwd_kernel, dim3(grid), dim3(512), LDS_BYTES, stream, a); }
#endif
}
```

```cpp
#include <hip/hip_runtime.h>
#include <hip/hip_cooperative_groups.h>
#include <cstdio>
#include <cstdint>
namespace cg = cooperative_groups;

#define LAS __attribute__((address_space(3)))
typedef unsigned short bf16_t;
typedef short bf16x8 __attribute__((ext_vector_type(8)));
typedef short s16x4 __attribute__((ext_vector_type(4)));
typedef float f32x4 __attribute__((ext_vector_type(4)));
typedef unsigned u32x4 __attribute__((ext_vector_type(4)));
typedef unsigned u32x2 __attribute__((ext_vector_type(2)));

__device__ __forceinline__ int lane_id();
__device__ __forceinline__ float shx(float v, int lane, int m) { return __builtin_bit_cast(float, __builtin_amdgcn_ds_bpermute((lane ^ m) << 2, __builtin_bit_cast(int, v))); }
#ifndef DBG_MASK
#define DBG_MASK 1023
#endif
#ifndef DUP_MASK
#define DUP_MASK 0
#endif
#ifndef MK_N_LAUNCHES
#define MK_N_LAUNCHES 1
#endif

constexpr int D = 1024, M = 16384, SEQ = 8192, DEPTH = 4, NH = 16, HD = 64, DFF = 2816, PLE = 256;
constexpr float EPS = 1e-6f;
constexpr int NPHASE = 1 + 8 * DEPTH;

constexpr size_t SZ_SS = (size_t)17 * M * 4;
constexpr size_t SZ_WGU = (size_t)2 * DFF * D * 2, SZ_WDN = (size_t)D * DFF * 2, SZ_WQKV = (size_t)3 * D * D * 2, SZ_WDD = (size_t)D * D * 2, SZ_WGRP = (size_t)4 * 256 * 256 * 2, SZ_WPROJ = (size_t)D * PLE * 2;
constexpr size_t WS_SS = 0;
constexpr size_t WS_BAR = 0x180000;
constexpr size_t WS_WGU = 2u << 20;
constexpr size_t WS_WDN = WS_WGU + 8 * SZ_WGU;
constexpr size_t WS_WQKV = WS_WDN + 8 * SZ_WDN;
constexpr size_t WS_WO = WS_WQKV + 2 * SZ_WQKV;
constexpr size_t WS_WIN = WS_WO + 2 * SZ_WDD;
constexpr size_t WS_WGRP = WS_WIN + 2 * SZ_WDD;
constexpr size_t WS_WGATE = WS_WGRP + 2 * SZ_WGRP;
constexpr size_t WS_WPROJ = WS_WGATE + 4 * SZ_WDD;
constexpr size_t WS_XB = WS_WPROJ + 4 * SZ_WPROJ;
constexpr size_t SZ_MD = (size_t)M * D * 2;
constexpr size_t WS_R1 = WS_XB + SZ_MD;
constexpr size_t WS_PB = WS_R1 + 4 * SZ_MD;
constexpr size_t WS_PE = WS_PB + SZ_MD;
constexpr size_t WS_END = WS_PE + SZ_MD;
static_assert(SZ_SS <= WS_WGU && (size_t)M * DFF * 2 <= 4 * SZ_MD, "ws map");

constexpr int LDS_BYTES = 131072 + 1024;

namespace pg8 {
constexpr int BM = 256, BK = 64, HALF = 128, HTB = HALF * BK * 2, STAGE_BYTES = 8 * HTB, NXCD = 8, WGM = 8;
__host__ __device__ __forceinline__ int lds_byte(int r, int c) { const int st = (r >> 4) * 2 + (c >> 5), rr = r & 15, cc = c & 31, ob = rr * 64 + cc * 2; return st * 1024 + (ob ^ (((ob >> 9) & 1) << 5)); }
__host__ __device__ __forceinline__ void stage_rc(int b, int& R, int& C) { const int st = b / 1024, sb = b % 1024, swz = sb ^ (((sb >> 9) & 1) << 5); R = (st >> 1) * 16 + swz / 64; C = (st & 1) * 32 + (swz % 64) / 2; }
__host__ __device__ __forceinline__ int perm32(int rho) { const int n = rho >> 4, i = rho & 15; return 8 * (i >> 2) + 4 * n + (i & 3); }

struct Unit { int pm, pn; };
struct Gemm { const bf16_t* A; const bf16_t* Bt; int lda, ldb, K; int a_pn_off; };

struct StaticOrder {
    int nM, nN, nwg, G, c;
    __device__ void init(int M_, int N_, int G_, int c_) { nM = M_ / BM; nN = N_ / BM; nwg = nM * nN; G = G_; c = c_; }
    __device__ bool next(int i, Unit& u) const {
        const int L = i * G + c; if (L >= nwg) return false;
        int wgid = L; { const int q = nwg / NXCD, r = nwg % NXCD, xcd = wgid % NXCD, off = wgid / NXCD; wgid = (xcd < r ? xcd * (q + 1) : r * (q + 1) + (xcd - r) * q) + off; }
        const int nig = WGM * nN, gid = wgid / nig, fm = gid * WGM, gsz = (nM - fm) < WGM ? (nM - fm) : WGM;
        u.pm = fm + ((wgid % nig) % gsz); u.pn = (wgid % nig) / gsz; return true;
    }
};

__device__ __forceinline__ unsigned cvt_pk_bf16(float lo, float hi) { unsigned r; asm volatile("v_cvt_pk_bf16_f32 %0, %1, %2" : "=v"(r) : "v"(lo), "v"(hi)); return r; }
__device__ __forceinline__ u32x4 pack8(const f32x4 a, const f32x4 b) { u32x4 w; w.x = cvt_pk_bf16(a[0], a[1]); w.y = cvt_pk_bf16(a[2], a[3]); w.z = cvt_pk_bf16(b[0], b[1]); w.w = cvt_pk_bf16(b[2], b[3]); return w; }
__device__ __forceinline__ float bf_lo(unsigned w) { return __uint_as_float(w << 16); }
__device__ __forceinline__ float bf_hi(unsigned w) { return __uint_as_float(w & 0xffff0000u); }
__device__ __forceinline__ float fast_sigmoid(float v) { return __builtin_amdgcn_rcpf(1.0f + __expf(-v)); }

typedef f32x4 Acc[2][2][4][2];

struct EpiGU {
    const float* ss; bf16_t* act;
    __device__ __forceinline__ void operator()(const Acc& acc, const Unit& u, int wr, int wc, int fr, int fq) const {
        const int row0 = u.pm * BM + wr * 64 + fr, col = u.pn * 128 + wc * 32 + 8 * fq;
#pragma unroll
        for (int ai = 0; ai < 2; ++ai)
#pragma unroll
            for (int m = 0; m < 4; ++m) {
                const int row = row0 + ai * HALF + m * 16;
                const float rinv = rsqrtf(ss[row] * (1.0f / D) + EPS);
                f32x4 o[2];
#pragma unroll
                for (int n = 0; n < 2; ++n) {
                    const f32x4 g = acc[ai][0][m][n] * rinv, up = acc[ai][1][m][n] * rinv;
#pragma unroll
                    for (int e = 0; e < 4; ++e) o[n][e] = g[e] * fast_sigmoid(g[e]) * up[e];
                }
                *(u32x4*)(act + (size_t)row * DFF + col) = pack8(o[0], o[1]);
            }
    }
};
template <int MODE> struct EpiRes {
    float* X; bf16_t* XB; float* ss_next; float alpha; const float* colscale; const float* ss_cur; const bf16_t* pe;
    __device__ __forceinline__ void operator()(const Acc& acc, const Unit& u, int wr, int wc, int fr, int fq) const {
        const int row0 = u.pm * BM + wr * 64 + fr, colb = u.pn * BM + wc * 32 + 8 * fq;
#pragma unroll
        for (int ai = 0; ai < 2; ++ai)
#pragma unroll
            for (int m = 0; m < 4; ++m) {
                const int row = row0 + ai * HALF + m * 16;
                float rinv = 1.f; if (MODE == 2) rinv = rsqrtf(ss_cur[row] * (1.0f / D) + EPS);
                float s2 = 0.f;
#pragma unroll
                for (int bj = 0; bj < 2; ++bj) {
                    const int col = colb + bj * HALF; const size_t off = (size_t)row * D + col;
                    f32x4 x0 = *(const f32x4*)(X + off), x1 = *(const f32x4*)(X + off + 4);
                    f32x4 v0 = acc[ai][bj][m][0], v1 = acc[ai][bj][m][1];
                    if (MODE == 0) { v0 = v0 * alpha; v1 = v1 * alpha; }
                    if (MODE == 1) { v0 = v0 * *(const f32x4*)(colscale + col); v1 = v1 * *(const f32x4*)(colscale + col + 4); }
                    if (MODE == 2) {
                        const u32x4 pw = *(const u32x4*)(pe + off);
                        const f32x4 p0 = {bf_lo(pw.x), bf_hi(pw.x), bf_lo(pw.y), bf_hi(pw.y)}, p1 = {bf_lo(pw.z), bf_hi(pw.z), bf_lo(pw.w), bf_hi(pw.w)};
#pragma unroll
                        for (int e = 0; e < 4; ++e) { v0[e] = fast_sigmoid(v0[e] * rinv) * p0[e]; v1[e] = fast_sigmoid(v1[e] * rinv) * p1[e]; }
                    }
                    x0 = x0 + v0; x1 = x1 + v1;
                    *(f32x4*)(X + off) = x0; *(f32x4*)(X + off + 4) = x1;
                    *(u32x4*)(XB + off) = pack8(x0, x1);
                    s2 += (x0[0] * x0[0] + x0[1] * x0[1]) + (x0[2] * x0[2] + x0[3] * x0[3]) + (x1[0] * x1[0] + x1[1] * x1[1]) + (x1[2] * x1[2] + x1[3] * x1[3]);
                }
                s2 += shx(s2, fq * 16 + fr, 16); s2 += shx(s2, fq * 16 + fr, 32);
                if (fq == 0) unsafeAtomicAdd(ss_next + row, s2);
                asm volatile("" ::: "memory");
            }
    }
};
struct EpiQKV {
    const float* ss; bf16_t* Q; const float* qg; const float* kg;
    __device__ __forceinline__ void operator()(const Acc& acc, const Unit& u, int wr, int wc, int fr, int fq) const {
        const int which = u.pn >> 2, pnl = u.pn & 3;
        bf16_t* dst = Q + (size_t)which * M * D;
        const int row0 = u.pm * BM + wr * 64 + fr, colb = pnl * 256 + wc * 64 + 8 * fq;
        const float* gp = which == 0 ? qg : kg;
        f32x4 gn[2][2];
#pragma unroll
        for (int bj = 0; bj < 2; ++bj)
#pragma unroll
            for (int n = 0; n < 2; ++n) gn[bj][n] = *(const f32x4*)(gp + 32 * bj + 8 * fq + 4 * n);
        const float qs = which == 0 ? 0.125f : 1.0f;
#pragma unroll
        for (int ai = 0; ai < 2; ++ai)
#pragma unroll
            for (int m = 0; m < 4; ++m) {
                const int row = row0 + ai * HALF + m * 16;
                const float rinv = rsqrtf(ss[row] * (1.0f / D) + EPS);
                f32x4 v[2][2]; float s2 = 0.f;
#pragma unroll
                for (int bj = 0; bj < 2; ++bj)
#pragma unroll
                    for (int n = 0; n < 2; ++n) { v[bj][n] = acc[ai][bj][m][n] * rinv; const f32x4 t = v[bj][n]; s2 += (t[0] * t[0] + t[1] * t[1]) + (t[2] * t[2] + t[3] * t[3]); }
                s2 += shx(s2, fq * 16 + fr, 16); s2 += shx(s2, fq * 16 + fr, 32);
                if (which < 2) {
                    const float hr = rsqrtf(s2 * (1.0f / HD) + EPS) * qs;
#pragma unroll
                    for (int bj = 0; bj < 2; ++bj)
#pragma unroll
                        for (int n = 0; n < 2; ++n) v[bj][n] = v[bj][n] * hr * gn[bj][n];
                }
#pragma unroll
                for (int bj = 0; bj < 2; ++bj) *(u32x4*)(dst + (size_t)row * D + colb + 32 * bj) = pack8(v[bj][0], v[bj][1]);
            }
    }
};
template <bool RINV> struct EpiBf16S {
    const float* ss; bf16_t* O; int ldc;
    __device__ __forceinline__ void operator()(const Acc& acc, const Unit& u, int wr, int wc, int fr, int fq) const {
        const int row0 = u.pm * BM + wr * 64 + fr, colb = u.pn * BM + wc * 32 + 8 * fq;
#pragma unroll
        for (int ai = 0; ai < 2; ++ai)
#pragma unroll
            for (int m = 0; m < 4; ++m) {
                const int row = row0 + ai * HALF + m * 16;
                float rinv = 1.f; if (RINV) rinv = rsqrtf(ss[row] * (1.0f / D) + EPS);
#pragma unroll
                for (int bj = 0; bj < 2; ++bj) *(u32x4*)(O + (size_t)row * ldc + colb + bj * HALF) = pack8(acc[ai][bj][m][0] * rinv, acc[ai][bj][m][1] * rinv);
            }
    }
};

template <class Epi, bool ALIGN_EPI>
__device__ __forceinline__ void gemm_phase(LAS unsigned char* lds, const Gemm g, const StaticOrder& S, const Epi& E, int wv) {
    int tid_ = wv * 64 + lane_id(); asm volatile("" : "+v"(tid_));
    const int tid = tid_, wid = __builtin_amdgcn_readfirstlane(tid >> 6), lane = tid & 63, wr = wid >> 2, wc = wid & 3, fr = lane & 15, fq = lane >> 4;
    const int K = g.K, nt = K / BK;
    unsigned voffA[2], voffB[2];
#pragma unroll
    for (int i = 0; i < 2; ++i) { int R, C; stage_rc(tid * 16 + i * 8192, R, C); const int Rb = (R & ~31) + perm32(R & 31);
        voffA[i] = (unsigned)(R * g.lda + C) * 2u; voffB[i] = (unsigned)(Rb * g.ldb + C) * 2u; }
    const size_t kstep = (size_t)(BK * 2);
    const size_t hstepA = (size_t)HALF * g.lda * 2, hstepB = (size_t)HALF * g.ldb * 2;
    const size_t tstepA = 2 * hstepA, tstepB = 2 * hstepB;
    const unsigned ldsw = (unsigned)wid * 1024u;
    const int aoff = lds_byte(wr * 64 + fr, fq * 8), boff = lds_byte(wc * 32 + fr, fq * 8);
#define PG8_SA(b, h) (((b) * 2 + (h)) * HTB)
#define PG8_SB(b, h) ((4 + (b) * 2 + (h)) * HTB)
#define PG8_STAGE(bufoff, gbase, voff) do { _Pragma("unroll") for (int _i = 0; _i < 2; ++_i) \
        __builtin_amdgcn_global_load_lds((const unsigned*)((const char*)(gbase) + (voff)[_i]), (LAS unsigned*)(lds + (bufoff) + ldsw + _i * 8192), 16, 0, 0); } while (0)
#define PG8_LDA(dst, b, h) do { _Pragma("unroll") for (int m = 0; m < 4; ++m) _Pragma("unroll") for (int k = 0; k < 2; ++k) dst[m][k] = *(const LAS bf16x8*)(lds + PG8_SA(b, h) + aoff + m * 2048 + k * 1024); } while (0)
#define PG8_LDB(dst, b, h) do { _Pragma("unroll") for (int n = 0; n < 2; ++n) _Pragma("unroll") for (int k = 0; k < 2; ++k) dst[n][k] = *(const LAS bf16x8*)(lds + PG8_SB(b, h) + boff + n * 2048 + k * 1024); } while (0)
#define PG8_MMA(ai, bj, At, Bt) do { __builtin_amdgcn_s_setprio(1); _Pragma("unroll") for (int m = 0; m < 4; ++m) _Pragma("unroll") for (int n = 0; n < 2; ++n) _Pragma("unroll") for (int k = 0; k < 2; ++k) \
        acc[ai][bj][m][n] = __builtin_amdgcn_mfma_f32_16x16x32_bf16(Bt[n][k], At[m][k], acc[ai][bj][m][n], 0, 0, 0); __builtin_amdgcn_s_setprio(0); } while (0)
#define PG8_WAIT_V(n) asm volatile("s_waitcnt vmcnt(" #n ")" ::: "memory")
#define PG8_WAIT_L(n) asm volatile("s_waitcnt lgkmcnt(" #n ")" ::: "memory")
#define PG8_BAR __builtin_amdgcn_s_barrier()
#define PG8_SCHED __builtin_amdgcn_sched_barrier(0)
    Unit cur, nxt; int ui = 0;
    if (!S.next(0, cur)) return;
    Acc acc;
#pragma unroll
    for (int a = 0; a < 2; ++a)
#pragma unroll
        for (int b = 0; b < 2; ++b)
#pragma unroll
            for (int m = 0; m < 4; ++m)
#pragma unroll
                for (int n = 0; n < 2; ++n) acc[a][b][m][n] = (f32x4){0.f, 0.f, 0.f, 0.f};
    bf16x8 At[4][2], B0[2][2], B1[2][2];
    const char* cA = (const char*)g.A + (size_t)cur.pm * tstepA + (size_t)cur.pn * g.a_pn_off * 2; const char* cB = (const char*)g.Bt + (size_t)cur.pn * tstepB;
    PG8_STAGE(PG8_SB(0, 0), cB, voffB); PG8_STAGE(PG8_SB(0, 1), cB + hstepB, voffB); PG8_STAGE(PG8_SA(0, 0), cA, voffA); PG8_STAGE(PG8_SA(0, 1), cA + hstepA, voffA);
    if (wr == 1) PG8_BAR;
    PG8_WAIT_V(2); PG8_BAR;
    PG8_STAGE(PG8_SB(1, 0), cB + kstep, voffB); PG8_STAGE(PG8_SA(1, 0), cA + kstep, voffA); PG8_STAGE(PG8_SB(1, 1), cB + hstepB + kstep, voffB);
    PG8_WAIT_V(6); PG8_BAR;
    for (;;) {
        const bool has_next = S.next(ui + 1, nxt);
        const char* nA = has_next ? (const char*)g.A + (size_t)nxt.pm * tstepA + (size_t)nxt.pn * g.a_pn_off * 2 : cA; const char* nB = has_next ? (const char*)g.Bt + (size_t)nxt.pn * tstepB : cB;
        for (int t = 0; t < nt; t += 2) {
            const bool last = (t == nt - 2);
            const char* a1 = cA + (size_t)(t + 1) * kstep;
            const char* a2 = last ? nA : cA + (size_t)(t + 2) * kstep; const char* b2 = last ? nB : cB + (size_t)(t + 2) * kstep;
            const char* a3 = a2 + kstep; const char* b3 = b2 + kstep;
            PG8_LDB(B0, 0, 0); PG8_LDB(B1, 0, 1); PG8_SCHED; PG8_LDA(At, 0, 0); PG8_STAGE(PG8_SA(1, 1), a1 + hstepA, voffA);
            PG8_WAIT_V(8); PG8_WAIT_L(0); PG8_BAR; PG8_MMA(0, 0, At, B0); PG8_MMA(0, 1, At, B1); PG8_BAR; PG8_SCHED;
            PG8_LDA(At, 0, 1); PG8_STAGE(PG8_SB(0, 0), b2, voffB); PG8_STAGE(PG8_SB(0, 1), b2 + hstepB, voffB); PG8_STAGE(PG8_SA(0, 0), a2, voffA);
            PG8_WAIT_V(8); PG8_WAIT_L(0); PG8_BAR; PG8_MMA(1, 0, At, B0); PG8_MMA(1, 1, At, B1); PG8_BAR; PG8_SCHED;
            PG8_LDB(B0, 1, 0); PG8_LDB(B1, 1, 1); PG8_SCHED; PG8_LDA(At, 1, 0); PG8_STAGE(PG8_SA(0, 1), a2 + hstepA, voffA);
            PG8_WAIT_V(8); PG8_WAIT_L(0); PG8_BAR; PG8_MMA(0, 0, At, B0); PG8_MMA(0, 1, At, B1); PG8_BAR; PG8_SCHED;
            PG8_LDA(At, 1, 1); PG8_STAGE(PG8_SB(1, 0), b3, voffB); PG8_STAGE(PG8_SB(1, 1), b3 + hstepB, voffB); PG8_STAGE(PG8_SA(1, 0), a3, voffA);
            PG8_WAIT_V(8); PG8_WAIT_L(0); PG8_BAR; PG8_MMA(1, 0, At, B0); PG8_MMA(1, 1, At, B1); PG8_BAR; PG8_SCHED;
        }
        if constexpr (ALIGN_EPI) { if (wr == 0) PG8_BAR; }
        E(acc, cur, wr, wc, fr, fq);
        if (!has_next) break;
#pragma unroll
        for (int a = 0; a < 2; ++a)
#pragma unroll
            for (int b = 0; b < 2; ++b)
#pragma unroll
                for (int m = 0; m < 4; ++m)
#pragma unroll
                    for (int n = 0; n < 2; ++n) acc[a][b][m][n] = (f32x4){0.f, 0.f, 0.f, 0.f};
        cur = nxt; cA = nA; cB = nB; ++ui;
        if constexpr (ALIGN_EPI) { if (wr == 1) PG8_BAR; }
    }
    PG8_WAIT_V(0);
    if constexpr (!ALIGN_EPI) { if (wr == 0) PG8_BAR; }
    PG8_BAR;
#undef PG8_SA
#undef PG8_SB
#undef PG8_STAGE
#undef PG8_LDA
#undef PG8_LDB
#undef PG8_MMA
#undef PG8_WAIT_V
#undef PG8_WAIT_L
#undef PG8_BAR
#undef PG8_SCHED
}
}

__device__ __forceinline__ unsigned f2bf(float f) { unsigned u = __builtin_bit_cast(unsigned, f); return (u + 0x7fffu + ((u >> 16) & 1u)) >> 16; }
__device__ __forceinline__ unsigned pk2(float lo, float hi) { return f2bf(lo) | (f2bf(hi) << 16); }
__device__ __forceinline__ float wave_sum(float v, int lane) {
#pragma unroll
    for (int o = 1; o < 64; o <<= 1) v += shx(v, lane, o);
    return v;
}
template <int MAP> __device__ __forceinline__ int map_row(int n0) {
    if (MAP == 1) { const int up = n0 >= DFF ? 1 : 0, j = n0 - up * DFF; return 256 * (j >> 7) + 128 * up + (j & 127); }
    if (MAP == 2) { const int pn = n0 >> 8, r = n0 & 255, wc = r >> 6, bj = (r >> 5) & 1; return 256 * pn + 128 * bj + 32 * wc; }
    return n0;
}
template <int MAP> __device__ __forceinline__ void conv_item(const float* W, int K, int N, bf16_t* WT, const float* gain, LAS float* scr, int item, int lane) {
    const int nblk = N / 32, kb = item / nblk, nb = item % nblk, k0 = 64 * kb, n0 = 32 * nb;
#pragma unroll 8
    for (int i = 0; i < 32; ++i) { const int kk = 2 * i + (lane >> 5); float w = W[(size_t)(k0 + kk) * N + n0 + (lane & 31)]; if (gain) w *= gain[k0 + kk]; scr[kk * 33 + (lane & 31)] = w; }
    asm volatile("s_waitcnt lgkmcnt(0)" ::: "memory");
    const int c = lane & 7; const int r0 = map_row<MAP>(n0);
#pragma unroll
    for (int j = 0; j < 4; ++j) { const int n = (lane >> 3) + 8 * j; const LAS float* s = scr + (8 * c) * 33 + n;
        u32x4 o; o.x = pk2(s[0 * 33], s[1 * 33]); o.y = pk2(s[2 * 33], s[3 * 33]); o.z = pk2(s[4 * 33], s[5 * 33]); o.w = pk2(s[6 * 33], s[7 * 33]);
        *(u32x4*)(WT + (size_t)(r0 + n) * K + k0 + 8 * c) = o; }
    asm volatile("s_waitcnt lgkmcnt(0)" ::: "memory");
}

__device__ __forceinline__ int lane_id() { int l; asm volatile("v_mbcnt_lo_u32_b32 %0, -1, 0\n\tv_mbcnt_hi_u32_b32 %0, -1, %0" : "=v"(l)); return l; }
__device__ __forceinline__ int opaque_int(int v) { asm volatile("" : "+s"(v)); return v; }
__device__ __forceinline__ unsigned char* opaque_ptr(unsigned char* p) { asm volatile("" : "+s"(p)); return p; }
struct Args { const float* in[19]; float* out; unsigned char* ws; int ph_lo, ph_hi; };

template <int MAP> __device__ __forceinline__ void conv_mat(const float* W, int K, int N, bf16_t* WT, const float* gain, LAS float* scr, int gw, int NGW, int& off, int lane) {
    const int nitems = (K / 64) * (N / 32);
    int start = gw - off; if (start < 0) start += NGW;
    for (int it = start; it < nitems; it += NGW) conv_item<MAP>(W, K, N, WT, gain, scr, it, lane);
    off = (off + nitems) % NGW;
}

__device__ __forceinline__ void prologue(const Args& a, LAS unsigned char* lds, int G) {
    const int tid = threadIdx.x, lane = tid & 63, wave = tid >> 6;
    const int gw = blockIdx.x * 8 + wave, NGW = G * 8;
    unsigned char* ws = a.ws;
    if (blockIdx.x == 0) { unsigned* bw = (unsigned*)(ws + WS_BAR); for (int i = tid; i < 3456; i += 512) bw[i] = 0u; }
    { float* ss = (float*)(ws + WS_SS) + M; const int n4 = 16 * M / 4;
      for (int i = blockIdx.x * 512 + tid; i < n4; i += G * 512) ((f32x4*)ss)[i] = (f32x4){0.f, 0.f, 0.f, 0.f}; }
    { float* ss0 = (float*)(ws + WS_SS); bf16_t* xb = (bf16_t*)(ws + WS_XB);
      for (int m = gw; m < M; m += NGW) {
          const f32x4* xr = (const f32x4*)(a.in[0] + (size_t)m * D) + lane; f32x4* orow = (f32x4*)(a.out + (size_t)m * D) + lane;
          u32x2* brow = (u32x2*)(xb + (size_t)m * D) + lane; float s = 0.f;
#pragma unroll
          for (int j = 0; j < 4; ++j) { const f32x4 v = xr[64 * j]; orow[64 * j] = v; u32x2 w; w.x = pk2(v[0], v[1]); w.y = pk2(v[2], v[3]); brow[64 * j] = w; s += (v[0] * v[0] + v[1] * v[1]) + (v[2] * v[2] + v[3] * v[3]); }
          s = wave_sum(s, lane); if (lane == 0) ss0[m] = s;
      } }
    { const f32x4* p4 = (const f32x4*)a.in[1]; u32x4* pb = (u32x4*)(ws + WS_PB); const int n8 = DEPTH * M * PLE / 8;
      for (int i = blockIdx.x * 512 + tid; i < n8; i += G * 512) { const f32x4 v0 = p4[2 * i], v1 = p4[2 * i + 1]; u32x4 w; w.x = pk2(v0[0], v0[1]); w.y = pk2(v0[2], v0[3]); w.z = pk2(v1[0], v1[1]); w.w = pk2(v1[2], v1[3]); pb[i] = w; } }
    LAS float* scr = (LAS float*)(lds + wave * 8704);
    int off = 0;
#pragma unroll 1
    for (int l = 0; l < DEPTH; ++l) {
        conv_mat<1>(a.in[3] + (size_t)l * D * 2 * DFF, D, 2 * DFF, (bf16_t*)(ws + WS_WGU + (size_t)(2 * l) * SZ_WGU), a.in[2] + l * D, scr, gw, NGW, off, lane);
        conv_mat<1>(a.in[14] + (size_t)l * D * 2 * DFF, D, 2 * DFF, (bf16_t*)(ws + WS_WGU + (size_t)(2 * l + 1) * SZ_WGU), a.in[13] + l * D, scr, gw, NGW, off, lane);
        conv_mat<0>(a.in[4] + (size_t)l * DFF * D, DFF, D, (bf16_t*)(ws + WS_WDN + (size_t)(2 * l) * SZ_WDN), nullptr, scr, gw, NGW, off, lane);
        conv_mat<0>(a.in[15] + (size_t)l * DFF * D, DFF, D, (bf16_t*)(ws + WS_WDN + (size_t)(2 * l + 1) * SZ_WDN), nullptr, scr, gw, NGW, off, lane);
        conv_mat<0>(a.in[17] + (size_t)l * D * D, D, D, (bf16_t*)(ws + WS_WGATE + (size_t)l * SZ_WDD), a.in[16] + l * D, scr, gw, NGW, off, lane);
        conv_mat<0>(a.in[18] + (size_t)l * PLE * D, PLE, D, (bf16_t*)(ws + WS_WPROJ + (size_t)l * SZ_WPROJ), nullptr, scr, gw, NGW, off, lane);
    }
#pragma unroll 1
    for (int j = 0; j < 2; ++j) {
        conv_mat<2>(a.in[6] + (size_t)j * D * 3 * D, D, 3 * D, (bf16_t*)(ws + WS_WQKV + (size_t)j * SZ_WQKV), a.in[5] + (2 * j) * D, scr, gw, NGW, off, lane);
        conv_mat<0>(a.in[9] + (size_t)j * D * D, D, D, (bf16_t*)(ws + WS_WO + (size_t)j * SZ_WDD), nullptr, scr, gw, NGW, off, lane);
        conv_mat<0>(a.in[10] + (size_t)j * D * D, D, D, (bf16_t*)(ws + WS_WIN + (size_t)j * SZ_WDD), a.in[5] + (2 * j + 1) * D, scr, gw, NGW, off, lane);
#pragma unroll 1
        for (int g = 0; g < 4; ++g)
            conv_mat<0>(a.in[11] + (size_t)(j * 4 + g) * 256 * 256, 256, 256, (bf16_t*)(ws + WS_WGRP + (size_t)j * SZ_WGRP + (size_t)g * 256 * 256 * 2), nullptr, scr, gw, NGW, off, lane);
    }
}

__device__ __forceinline__ void unpack8(const u32x4 w, float* f) {
    f[0] = pg8::bf_lo(w.x); f[1] = pg8::bf_hi(w.x); f[2] = pg8::bf_lo(w.y); f[3] = pg8::bf_hi(w.y); f[4] = pg8::bf_lo(w.z); f[5] = pg8::bf_hi(w.z); f[6] = pg8::bf_lo(w.w); f[7] = pg8::bf_hi(w.w);
}
__device__ __forceinline__ void pool_phase(const bf16_t* U, bf16_t* P, int G, int wv) {
    int tid_ = wv * 64 + lane_id(); asm volatile("" : "+v"(tid_));
    for (int item = blockIdx.x * 512 + tid_; item < (M / 16) * 128; item += G * 512) {
        const int chunk = item & 127, strip = item >> 7, row0 = strip * 16, t0 = row0 & (SEQ - 1);
        const int w = 2 << (chunk >> 5);
        const bf16_t* up = U + (size_t)row0 * D + chunk * 8; bf16_t* pp = P + (size_t)row0 * D + chunk * 8;
        float S[8];
#pragma unroll
        for (int e = 0; e < 8; ++e) S[e] = 0.f;
        for (int j = 1; j < w; ++j) if (t0 - j >= 0) { float f[8]; unpack8(*(const u32x4*)(up - (ptrdiff_t)j * D), f);
#pragma unroll
            for (int e = 0; e < 8; ++e) S[e] += f[e]; }
#pragma unroll 4
        for (int r = 0; r < 16; ++r) {
            const int t = t0 + r; float cur[8]; unpack8(*(const u32x4*)(up + (ptrdiff_t)r * D), cur);
            const float ic = 1.0f / (float)(t + 1 < w ? t + 1 : w); float o[8];
#pragma unroll
            for (int e = 0; e < 8; ++e) { S[e] += cur[e]; o[e] = S[e] * ic - cur[e]; }
            u32x4 ow; ow.x = pk2(o[0], o[1]); ow.y = pk2(o[2], o[3]); ow.z = pk2(o[4], o[5]); ow.w = pk2(o[6], o[7]);
            *(u32x4*)(pp + (ptrdiff_t)r * D) = ow;
            if (t - w + 1 >= 0) { float f[8]; unpack8(*(const u32x4*)(up + (ptrdiff_t)(r - w + 1) * D), f);
#pragma unroll
                for (int e = 0; e < 8; ++e) S[e] -= f[e]; }
        }
    }
}

__device__ __forceinline__ void attn_phase(LAS unsigned char* lds, const bf16_t* Q, const bf16_t* Kg, const bf16_t* Vg, bf16_t* O, int G, int wv) {
    LAS bf16_t* Ks = (LAS bf16_t*)lds;
    LAS bf16_t* Vt = (LAS bf16_t*)(lds + 9216);
    LAS unsigned* flags = (LAS unsigned*)(lds + 9216 + 8704);
    int tid_ = wv * 64 + lane_id(); asm volatile("" : "+v"(tid_));
    const int tid = tid_, wid = tid >> 6, lane = tid & 63, l16 = lane & 15, g = lane >> 4;
    for (int unit = blockIdx.x; unit < 2 * NH * (SEQ / 128); unit += G) {
        const int qblk = unit & 63, bh = unit >> 6, b = bh >> 4, h = bh & 15;
        const size_t rowbase = (size_t)b * SEQ; const int t0 = qblk * 128 + wid * 16, tq = t0 + l16;
        bf16x8 qf[2];
        { const bf16_t* qp = Q + (rowbase + tq) * D + h * HD + 8 * g; qf[0] = *(const bf16x8*)qp; qf[1] = *(const bf16x8*)(qp + 32); }
        f32x4 o[4];
#pragma unroll
        for (int i = 0; i < 4; ++i) o[i] = (f32x4){0.f, 0.f, 0.f, 0.f};
        float carry = 0.f; unsigned wave_done = 0u;
        for (int kt = 2 * qblk + 1; kt >= 0; --kt) {
            if (lane == 0) flags[wid] = wave_done;
            __syncthreads();
            unsigned all = 1u;
#pragma unroll
            for (int i = 0; i < 8; ++i) all &= flags[i];
            if (all) break;
            { const int key = tid >> 3, dc = tid & 7; const size_t src = (rowbase + (size_t)kt * 64 + key) * D + h * HD + 8 * dc;
              const u32x4 kv = *(const u32x4*)(Kg + src); const u32x4 vv = *(const u32x4*)(Vg + src);
              *(LAS u32x4*)(Ks + key * 72 + 8 * dc) = kv;
              LAS bf16_t* vd = Vt + (8 * dc) * 68 + key;
              vd[0 * 68] = (bf16_t)(vv.x & 0xffffu); vd[1 * 68] = (bf16_t)(vv.x >> 16); vd[2 * 68] = (bf16_t)(vv.y & 0xffffu); vd[3 * 68] = (bf16_t)(vv.y >> 16);
              vd[4 * 68] = (bf16_t)(vv.z & 0xffffu); vd[5 * 68] = (bf16_t)(vv.z >> 16); vd[6 * 68] = (bf16_t)(vv.w & 0xffffu); vd[7 * 68] = (bf16_t)(vv.w >> 16); }
            __syncthreads();
            if (kt * 64 <= t0 + 14) {
                f32x4 z[4];
#pragma unroll
                for (int bb = 0; bb < 4; ++bb) { z[bb] = (f32x4){0.f, 0.f, 0.f, 0.f};
#pragma unroll
                    for (int ks = 0; ks < 2; ++ks) { const bf16x8 ka = *(const LAS bf16x8*)(Ks + (16 * bb + l16) * 72 + 32 * ks + 8 * g); z[bb] = __builtin_amdgcn_mfma_f32_16x16x32_bf16(ka, qf[ks], z[bb], 0, 0, 0); } }
                float sp[4][4], tot[4], Ex[4];
#pragma unroll
                for (int bb = 0; bb < 4; ++bb) {
                    float T = 0.f;
#pragma unroll
                    for (int i = 0; i < 4; ++i) { const int s = kt * 64 + 16 * bb + 4 * g + i; const float zz = z[bb][i];
                        const float v = fmaxf(zz, 0.f) + __logf(1.0f + __expf(-fabsf(zz))); sp[bb][i] = (s < tq) ? v : 0.f; T += sp[bb][i]; }
                    const float a_ = shx(T, lane, 16), b2 = T + a_, c_ = shx(b2, lane, 32);
                    tot[bb] = b2 + c_; Ex[bb] = ((g & 1) == 0 ? a_ : 0.f) + ((g & 2) == 0 ? c_ : 0.f);
                }
                float wv[4][4]; float right = 0.f;
#pragma unroll
                for (int bb = 3; bb >= 0; --bb) {
                    const float base = carry - right - Ex[bb]; float run = 0.f;
#pragma unroll
                    for (int i = 3; i >= 0; --i) { const int s = kt * 64 + 16 * bb + 4 * g + i; run += sp[bb][i]; const float F = base - run; wv[bb][i] = (s < tq) ? __expf(z[bb][i] + F) : 0.f; }
                    right += tot[bb];
                }
                carry -= right;
#pragma unroll
                for (int c = 0; c < 2; ++c) {
                    u32x4 pw; pw.x = pg8::cvt_pk_bf16(wv[2 * c][0], wv[2 * c][1]); pw.y = pg8::cvt_pk_bf16(wv[2 * c][2], wv[2 * c][3]);
                    pw.z = pg8::cvt_pk_bf16(wv[2 * c + 1][0], wv[2 * c + 1][1]); pw.w = pg8::cvt_pk_bf16(wv[2 * c + 1][2], wv[2 * c + 1][3]);
                    const bf16x8 pbf = __builtin_bit_cast(bf16x8, pw);
#pragma unroll
                    for (int db = 0; db < 4; ++db) {
                        const LAS bf16_t* vp = Vt + (16 * db + l16) * 68 + 32 * c + 4 * g;
                        const u32x2 v0 = *(const LAS u32x2*)vp, v1 = *(const LAS u32x2*)(vp + 16);
                        u32x4 va; va.x = v0.x; va.y = v0.y; va.z = v1.x; va.w = v1.y;
                        o[db] = __builtin_amdgcn_mfma_f32_16x16x32_bf16(__builtin_bit_cast(bf16x8, va), pbf, o[db], 0, 0, 0);
                    }
                }
                wave_done = (__builtin_amdgcn_ballot_w64(carry < -105.0f) == ~0ull) ? 1u : 0u;
            }
        }
        __syncthreads();
        { bf16_t* op = O + (rowbase + tq) * D + h * HD + 4 * g;
#pragma unroll
          for (int db = 0; db < 4; ++db) { u32x2 w; w.x = pg8::cvt_pk_bf16(o[db][0], o[db][1]); w.y = pg8::cvt_pk_bf16(o[db][2], o[db][3]); *(u32x2*)(op + 16 * db) = w; } }
    }
}

#define XB_TMO      128
#define XB_XCNT(j)  (256  + 64 * (j))
#define XB_XSUB(j)  (1280 + 64 * (j))
#define XB_XGEN(j)  (2304 + 64 * (j))
#define XB_TOP      3328
#define XB_TOPGEN   3392
#define XCD_BAR_WORDS 3456
#define XB_SPIN_CAP (1u << 18)
__device__ __forceinline__ unsigned xb_ld(unsigned* p)              { return __hip_atomic_load(p, __ATOMIC_RELAXED, __HIP_MEMORY_SCOPE_AGENT); }
__device__ __forceinline__ unsigned xb_add(unsigned* p, unsigned v) { return __hip_atomic_fetch_add(p, v, __ATOMIC_RELAXED, __HIP_MEMORY_SCOPE_AGENT); }
__device__ __forceinline__ unsigned xb_xcc_id() { return (unsigned)__builtin_amdgcn_s_getreg((3 << 11) | 20) & 0xFu; }
#define XB_SPIN(cond, bar) do { unsigned _sp = 0; while (cond) { __builtin_amdgcn_s_sleep(1); \
    if ((++_sp & 255u) == 0u) { if (xb_ld(&(bar)[XB_TMO])) break; if (_sp > XB_SPIN_CAP) { atomicAdd(&(bar)[XB_TMO], 1u); break; } } } } while (0)
struct XcdBarrier { unsigned* bar; unsigned x; volatile LAS unsigned* st; };
__device__ __forceinline__ XcdBarrier xcd_barrier_post(unsigned* bar, volatile LAS unsigned* st) {
    XcdBarrier b; b.bar = bar; b.x = xb_xcc_id(); b.st = st;
    if (threadIdx.x == 0) (void)xb_add(&bar[XB_XCNT(b.x)], 1u);
    return b;
}
__device__ __forceinline__ void xcd_barrier_complete(unsigned* bar, unsigned x, unsigned& nloc, unsigned& nx) {
    const unsigned G = gridDim.x * gridDim.y * gridDim.z;
    unsigned sum, cnt, mine, sp = 0u;
    for (;;) {
        sum = 0u; cnt = 0u; mine = 0u;
#pragma unroll
        for (unsigned j = 0; j < 16; ++j) { const unsigned c = xb_ld(&bar[XB_XCNT(j)]); sum += c; cnt += (c > 0u) ? 1u : 0u; mine = (j == x) ? c : mine; }
        if (sum == G) break;
        __builtin_amdgcn_s_sleep(1);
        if ((++sp & 255u) == 0u) { if (xb_ld(&bar[XB_TMO])) break; if (sp > XB_SPIN_CAP) { atomicAdd(&bar[XB_TMO], 1u); break; } }
    }
    nloc = mine > 0u ? mine : 1u; nx = cnt > 0u ? cnt : 1u;
}
__device__ __forceinline__ void xcd_barrier(const XcdBarrier& b, int wv) {
    asm volatile("s_waitcnt vmcnt(0)" ::: "memory");
    __syncthreads();
    if (wv == 0 && lane_id() == 0) {
        unsigned* bar = b.bar; asm volatile("" : "+s"(bar));
        __builtin_amdgcn_s_waitcnt(0);
        unsigned nloc = b.st[0], nx = b.st[1];
        if (nloc == 0u) { xcd_barrier_complete(bar, b.x, nloc, nx); b.st[0] = nloc; b.st[1] = nx; }
        const unsigned old = xb_add(&bar[XB_XSUB(b.x)], 1u);
        const unsigned gen = old / nloc;
        if (old + 1u == (gen + 1u) * nloc) {
            __builtin_amdgcn_fence(__ATOMIC_RELEASE, "agent");
            asm volatile("s_waitcnt vmcnt(0)" ::: "memory");
            const unsigned og = xb_add(&bar[XB_TOP], 1u);
            const unsigned tg = og / nx;
            if (og + 1u == (tg + 1u) * nx) xb_add(&bar[XB_TOPGEN], 1u);
            else XB_SPIN(xb_ld(&bar[XB_TOPGEN]) == tg, bar);
            __builtin_amdgcn_fence(__ATOMIC_ACQUIRE, "agent");
            xb_add(&bar[XB_XGEN(b.x)], 1u);
            asm volatile("s_waitcnt vmcnt(0)" ::: "memory");
        } else {
            XB_SPIN(xb_ld(&bar[XB_XGEN(b.x)]) == gen, bar);
            __builtin_amdgcn_fence(__ATOMIC_ACQUIRE, "agent");
            asm volatile("s_waitcnt vmcnt(0)" ::: "memory");
        }
    }
    __syncthreads();
}

__global__ void __launch_bounds__(512, 2) fwd_kernel(Args a) {
    extern __shared__ __attribute__((aligned(16))) unsigned char lds_raw[];
    LAS unsigned char* lds = (LAS unsigned char*)lds_raw;
    const int G0 = gridDim.x, bid0 = blockIdx.x, wv = __builtin_amdgcn_readfirstlane(threadIdx.x >> 6);
    unsigned char* ws0 = a.ws; float* X = a.out;
    volatile LAS unsigned* bst = (volatile LAS unsigned*)(lds + 131072 + 64);
    if (threadIdx.x < 2) bst[threadIdx.x] = 0u;
    __syncthreads();
    XcdBarrier xbar; xbar.bar = (unsigned*)(ws0 + WS_BAR); xbar.x = 0; xbar.st = bst;
#define REP(bit) _Pragma("unroll 1") for (int rep_ = 0, nrep_ = opaque_int((DUP_MASK & (bit)) ? 2 : 1); rep_ < nrep_; ++rep_)
#if MK_N_LAUNCHES == 1
#define IN(k) true
#define SEAM(k) do { xcd_barrier(xbar, wv); if (DUP_MASK & 2) xcd_barrier(xbar, wv); } while (0)
#define SEAM0() do { cg::this_grid().sync(); xbar = xcd_barrier_post((unsigned*)(ws0 + WS_BAR), bst); } while (0)
#else
    const int lo = a.ph_lo, hi = a.ph_hi;
#define IN(k) (lo <= (k) && (k) < hi)
#define SEAM(k) do { if (lo < (k) && (k) < hi) cg::this_grid().sync(); } while (0)
#define SEAM0() SEAM(1)
#endif
    if (IN(0)) { if (DBG_MASK & 1) { REP(1) { prologue(a, lds, G0); __syncthreads(); } } }
    SEAM0();
#pragma unroll 1
    for (int l = 0; l < DEPTH; ++l) {
        const int j = l >> 1, p0 = 1 + 8 * l; const bool is_attn = (l & 1) == 0;
        pg8::StaticOrder S;
#define OPQ() unsigned char* ws = opaque_ptr(ws0); const int G = opaque_int(G0), bid = opaque_int(bid0); float* SS = (float*)(ws + WS_SS); bf16_t* XB = (bf16_t*)(ws + WS_XB); bf16_t* R1 = (bf16_t*)(ws + WS_R1); \
        bf16_t* ACT = R1; bf16_t* Qb = R1; bf16_t* Kb = R1 + (size_t)M * D; bf16_t* Vb = R1 + (size_t)2 * M * D; bf16_t* Ob = R1 + (size_t)3 * M * D; bf16_t* Ub = R1; bf16_t* PLb = R1 + (size_t)M * D; bf16_t* PE = (bf16_t*)(ws + WS_PE); \
        (void)SS; (void)XB; (void)ACT; (void)Qb; (void)Kb; (void)Vb; (void)Ob; (void)Ub; (void)PLb; (void)PE; (void)G; (void)bid
#pragma unroll 1
        for (int f = 0; f < 2; ++f) {
            const int pa = p0 + 5 * f;
            if (pa != 1) SEAM(pa);
            if ((DBG_MASK & 2) && IN(pa)) {
                OPQ();
                pg8::Gemm g{XB, (const bf16_t*)(ws + WS_WGU + (size_t)(2 * l + f) * SZ_WGU), D, D, D, 0}; S.init(M, 2 * DFF, G, bid);
                pg8::EpiGU E{SS + (size_t)(4 * l + 2 * f) * M, ACT};
                REP(8) pg8::gemm_phase<pg8::EpiGU, true>(lds, g, S, E, wv);
            }
            SEAM(pa + 1);
            if ((DBG_MASK & 4) && IN(pa + 1)) {
                OPQ();
                pg8::Gemm g{ACT, (const bf16_t*)(ws + WS_WDN + (size_t)(2 * l + f) * SZ_WDN), DFF, DFF, DFF, 0}; S.init(M, D, G, bid);
                pg8::EpiRes<0> E{X, XB, SS + (size_t)(4 * l + 2 * f + 1) * M, 0.5f, nullptr, nullptr, nullptr};
                pg8::gemm_phase<pg8::EpiRes<0>, false>(lds, g, S, E, wv);
            }
            if (f == 0) {
                SEAM(p0 + 2);
                if (IN(p0 + 2)) {
                    OPQ();
                    if (is_attn) { if (DBG_MASK & 8) {
                        pg8::Gemm g{XB, (const bf16_t*)(ws + WS_WQKV + (size_t)j * SZ_WQKV), D, D, D, 0}; S.init(M, 3 * D, G, bid);
                        pg8::EpiQKV E{SS + (size_t)(4 * l + 1) * M, Qb, a.in[7] + j * HD, a.in[8] + j * HD};
                        REP(32) pg8::gemm_phase<pg8::EpiQKV, true>(lds, g, S, E, wv);
                    } } else if (DBG_MASK & 16) {
                        pg8::Gemm g{XB, (const bf16_t*)(ws + WS_WIN + (size_t)j * SZ_WDD), D, D, D, 0}; S.init(M, D, G, bid);
                        pg8::EpiBf16S<true> E{SS + (size_t)(4 * l + 1) * M, Ub, D};
                        REP(64) pg8::gemm_phase<pg8::EpiBf16S<true>, false>(lds, g, S, E, wv);
                    }
                }
                SEAM(p0 + 3);
                if (IN(p0 + 3)) {
                    OPQ();
                    if (is_attn) { if (DBG_MASK & 32) { REP(4) attn_phase(lds, Qb, Kb, Vb, Ob, G, wv); } }
                    else if (DBG_MASK & 64) { REP(128) pool_phase(Ub, PLb, G, wv); }
                }
                SEAM(p0 + 4);
                if (IN(p0 + 4)) {
                    OPQ();
                    if (is_attn) { if (DBG_MASK & 128) {
                        pg8::Gemm g{Ob, (const bf16_t*)(ws + WS_WO + (size_t)j * SZ_WDD), D, D, D, 0}; S.init(M, D, G, bid);
                        pg8::EpiRes<0> E{X, XB, SS + (size_t)(4 * l + 2) * M, 1.0f, nullptr, nullptr, nullptr};
                        pg8::gemm_phase<pg8::EpiRes<0>, false>(lds, g, S, E, wv);
                    } } else if (DBG_MASK & 256) {
                        pg8::Gemm g{PLb, (const bf16_t*)(ws + WS_WGRP + (size_t)j * SZ_WGRP), D, 256, 256, 256}; S.init(M, D, G, bid);
                        pg8::EpiRes<1> E{X, XB, SS + (size_t)(4 * l + 2) * M, 1.0f, a.in[12] + j * D, nullptr, nullptr};
                        pg8::gemm_phase<pg8::EpiRes<1>, false>(lds, g, S, E, wv);
                    }
                }
            }
        }
        SEAM(p0 + 7);
        if ((DBG_MASK & 512) && IN(p0 + 7)) {
            OPQ();
            { pg8::Gemm g{(const bf16_t*)(ws + WS_PB) + (size_t)l * M * PLE, (const bf16_t*)(ws + WS_WPROJ + (size_t)l * SZ_WPROJ), PLE, PLE, PLE, 0}; S.init(M, D, G, bid);
              pg8::EpiBf16S<false> E{nullptr, PE, D};
              REP(16) pg8::gemm_phase<pg8::EpiBf16S<false>, false>(lds, g, S, E, wv); }
            { pg8::Gemm g{XB, (const bf16_t*)(ws + WS_WGATE + (size_t)l * SZ_WDD), D, D, D, 0}; S.init(M, D, G, bid);
              pg8::EpiRes<2> E{X, XB, SS + (size_t)(4 * l + 4) * M, 1.0f, nullptr, SS + (size_t)(4 * l + 3) * M, PE};
              pg8::gemm_phase<pg8::EpiRes<2>, false>(lds, g, S, E, wv); }
        }
    }
#undef IN
#undef SEAM
#undef SEAM0
#undef OPQ
}

extern "C" void kernel_launch(void* const* d_in, const int* in_sizes, int n_in, void* d_out, int out_size, void* d_ws, size_t ws_size, hipStream_t stream) {
    static int grid = 0;
    if (grid == 0) {
        if (n_in != 19 || out_size != M * D || ws_size < WS_END) { fprintf(stderr, "kernel_launch: unexpected shapes (n_in %d, out %d, ws %zu, need %zu)\n", n_in, out_size, ws_size, (size_t)WS_END); grid = -1; return; }
        int dev = 0, cus = 0, per_cu = 0;
        hipGetDevice(&dev); hipDeviceGetAttribute(&cus, hipDeviceAttributeMultiprocessorCount, dev);
        if (hipFuncSetAttribute((const void*)fwd_kernel, hipFuncAttributeMaxDynamicSharedMemorySize, LDS_BYTES) != hipSuccess) { fprintf(stderr, "kernel_launch: hipFuncSetAttribute failed\n"); }
        if (hipOccupancyMaxActiveBlocksPerMultiprocessor(&per_cu, (const void*)fwd_kernel, 512, LDS_BYTES) != hipSuccess || per_cu < 1) per_cu = 1;
        (void)hipGetLastError();
        grid = cus * per_cu;
        fprintf(stderr, "kernel_launch: grid %d (cus %d x %d)\n", grid, cus, per_cu);
    }
    if (grid < 0) return;
    Args a{};
    for (int i = 0; i < 19; ++i) a.in[i] = (const float*)d_in[i];
    a.out = (float*)d_out; a.ws = (unsigned char*)d_ws;
#if MK_N_LAUNCHES == 1
    a.ph_lo = 0; a.ph_hi = NPHASE;
    void* args[] = {&a};
    hipError_t e = hipLaunchCooperativeKernel((const void*)fwd_kernel, dim3(grid), dim3(512), args, LDS_BYTES, stream);
    if (e != hipSuccess) fprintf(stderr, "cooperative launch failed: %s (grid %d)\n", hipGetErrorString(e), grid);
#else
    for (int ph = 0; ph < NPHASE; ++ph) { a.ph_lo = ph; a.ph_hi = ph + 1; hipLaunchKernelGGL(fwd_kernel, dim3(grid), dim3(512), LDS_BYTES, stream, a); }
#endif
}
```

```cpp
#include <hip/hip_runtime.h>
#include <hip/hip_cooperative_groups.h>
#include <cstdio>
#include <cstdint>
namespace cg = cooperative_groups;

#define LAS __attribute__((address_space(3)))
typedef unsigned short bf16_t;
typedef short bf16x8 __attribute__((ext_vector_type(8)));
typedef short s16x4 __attribute__((ext_vector_type(4)));
typedef float f32x4 __attribute__((ext_vector_type(4)));
typedef unsigned u32x4 __attribute__((ext_vector_type(4)));
typedef unsigned u32x2 __attribute__((ext_vector_type(2)));

__device__ __forceinline__ int lane_id();
__device__ __forceinline__ int opaque_int(int v);
__device__ __forceinline__ unsigned char* opaque_ptr(unsigned char* p);
__device__ __forceinline__ float shx(float v, int lane, int m) { return __builtin_bit_cast(float, __builtin_amdgcn_ds_bpermute((lane ^ m) << 2, __builtin_bit_cast(int, v))); }
#ifndef DBG_MASK
#define DBG_MASK 1023
#endif
#ifndef DUP_MASK
#define DUP_MASK 0
#endif
#ifndef MK_N_LAUNCHES
#define MK_N_LAUNCHES 1
#endif

constexpr int D = 1024, M = 16384, SEQ = 8192, DEPTH = 4, NH = 16, HD = 64, DFF = 2816, PLE = 256;
constexpr float EPS = 1e-6f;
constexpr int NPHASE = 1 + 8 * DEPTH;

constexpr size_t SZ_SS = (size_t)17 * M * 8;
constexpr size_t SZ_WGU = (size_t)2 * DFF * D * 2, SZ_WDN = (size_t)D * DFF * 2, SZ_WQKV = (size_t)3 * D * D * 2, SZ_WDD = (size_t)D * D * 2, SZ_WGRP = (size_t)4 * 256 * 256 * 2, SZ_WPROJ = (size_t)D * PLE * 2;
constexpr size_t WS_SS = 0;
constexpr size_t WS_BAR = 0x300000;
constexpr size_t WS_WGU = 4u << 20;
constexpr size_t WS_WDN = WS_WGU + 8 * SZ_WGU;
constexpr size_t WS_WQKV = WS_WDN + 8 * SZ_WDN;
constexpr size_t WS_WO = WS_WQKV + 2 * SZ_WQKV;
constexpr size_t WS_WIN = WS_WO + 2 * SZ_WDD;
constexpr size_t WS_WGRP = WS_WIN + 2 * SZ_WDD;
constexpr size_t WS_WGATE = WS_WGRP + 2 * SZ_WGRP;
constexpr size_t WS_WPROJ = WS_WGATE + 4 * SZ_WDD;
constexpr size_t WS_XB = WS_WPROJ + 4 * SZ_WPROJ;
constexpr size_t SZ_MD = (size_t)M * D * 2;
constexpr size_t WS_R1 = WS_XB + SZ_MD;
constexpr size_t WS_PB = WS_R1 + 4 * SZ_MD;
constexpr size_t WS_PE = WS_PB + SZ_MD;
constexpr size_t WS_XB2 = WS_PE + SZ_MD;
constexpr size_t WS_END = WS_XB2 + SZ_MD;
static_assert(SZ_SS <= WS_BAR && WS_BAR + 16384 <= WS_WGU && (size_t)M * DFF * 2 <= 4 * SZ_MD, "ws map");

constexpr int LDS_BYTES = 8 * 16640 + 256;

namespace pg8 {
constexpr int BM = 256, BK = 64, HALF = 128, HTB = HALF * BK * 2, STAGE_BYTES = 8 * HTB, NXCD = 8, WGM = 8;
__host__ __device__ __forceinline__ int lds_byte(int r, int c) { const int st = (r >> 4) * 2 + (c >> 5), rr = r & 15, cc = c & 31, ob = rr * 64 + cc * 2; return st * 1024 + (ob ^ (((ob >> 9) & 1) << 5)); }
__host__ __device__ __forceinline__ void stage_rc(int b, int& R, int& C) { const int st = b / 1024, sb = b % 1024, swz = sb ^ (((sb >> 9) & 1) << 5); R = (st >> 1) * 16 + swz / 64; C = (st & 1) * 32 + (swz % 64) / 2; }
__host__ __device__ __forceinline__ int perm32(int rho) { const int n = rho >> 4, i = rho & 15; return 8 * (i >> 2) + 4 * n + (i & 3); }

struct Unit { int pm, pn; };
struct Gemm { const bf16_t* A; const bf16_t* Bt; int lda, ldb, K; int a_pn_off; };

struct StaticOrder {
    int nM, nN, nwg, G, c;
    __device__ void init(int M_, int N_, int G_, int c_) { nM = M_ / BM; nN = N_ / BM; nwg = nM * nN; G = G_; c = c_; }
    __device__ bool next(int i, Unit& u) const {
        const int L = i * G + c; if (L >= nwg) return false;
        int wgid = L; { const int q = nwg / NXCD, r = nwg % NXCD, xcd = wgid % NXCD, off = wgid / NXCD; wgid = (xcd < r ? xcd * (q + 1) : r * (q + 1) + (xcd - r) * q) + off; }
        const int nig = WGM * nN, gid = wgid / nig, fm = gid * WGM, gsz = (nM - fm) < WGM ? (nM - fm) : WGM;
        u.pm = fm + ((wgid % nig) % gsz); u.pn = (wgid % nig) / gsz; return true;
    }
};

__device__ __forceinline__ unsigned cvt_pk_bf16(float lo, float hi) { unsigned r; asm volatile("v_cvt_pk_bf16_f32 %0, %1, %2" : "=v"(r) : "v"(lo), "v"(hi)); return r; }
__device__ __forceinline__ u32x4 pack8(const f32x4 a, const f32x4 b) { u32x4 w; w.x = cvt_pk_bf16(a[0], a[1]); w.y = cvt_pk_bf16(a[2], a[3]); w.z = cvt_pk_bf16(b[0], b[1]); w.w = cvt_pk_bf16(b[2], b[3]); return w; }
__device__ __forceinline__ float bf_lo(unsigned w) { return __uint_as_float(w << 16); }
__device__ __forceinline__ float bf_hi(unsigned w) { return __uint_as_float(w & 0xffff0000u); }
__device__ __forceinline__ float fast_sigmoid(float v) { return __builtin_amdgcn_rcpf(1.0f + __expf(-v)); }

typedef f32x4 Acc[2][2][4][2];
typedef long long ss_t;
__device__ __forceinline__ float ss_rinv(const ss_t* ss, int row) { return rsqrtf((float)ss[row] * (1.0f / (16777216.0f * D)) + EPS); }
__device__ __forceinline__ void ss_add(ss_t* ss, int row, float s2) { (void)__hip_atomic_fetch_add((unsigned long long*)(ss + row), (unsigned long long)__float2ll_rn(s2 * 16777216.0f), __ATOMIC_RELAXED, __HIP_MEMORY_SCOPE_AGENT); }

struct EpiGU {
    const ss_t* ss; bf16_t* act;
    __device__ __forceinline__ void operator()(const Acc& acc, const Unit& u, int wr, int wc, int fr, int fq) const {
        const int row0 = u.pm * BM + wr * 64 + fr, col = u.pn * 128 + wc * 32 + 8 * fq;
#pragma unroll
        for (int ai = 0; ai < 2; ++ai)
#pragma unroll
            for (int m = 0; m < 4; ++m) {
                const int row = row0 + ai * HALF + m * 16;
                const float rinv = ss_rinv(ss, row);
                f32x4 o[2];
#pragma unroll
                for (int n = 0; n < 2; ++n) {
                    const f32x4 g = acc[ai][0][m][n] * rinv, up = acc[ai][1][m][n] * rinv;
#pragma unroll
                    for (int e = 0; e < 4; ++e) o[n][e] = g[e] * fast_sigmoid(g[e]) * up[e];
                }
                *(u32x4*)(act + (size_t)row * DFF + col) = pack8(o[0], o[1]);
            }
    }
};
template <int MODE> struct EpiRes {
    const bf16_t* XR; bf16_t* XW; float* OUT; ss_t* ss_next; float alpha; const float* colscale; const ss_t* ss_cur; const bf16_t* pe;
    __device__ __forceinline__ void operator()(const Acc& acc, const Unit& u, int wr, int wc, int fr, int fq) const {
        const int row0 = u.pm * BM + wr * 64 + fr, colb = u.pn * BM + wc * 32 + 8 * fq;
#pragma unroll
        for (int ai = 0; ai < 2; ++ai)
#pragma unroll
            for (int m = 0; m < 4; ++m) {
                const int row = row0 + ai * HALF + m * 16;
                float rinv = 1.f; if (MODE == 2) rinv = ss_rinv(ss_cur, row);
                float s2 = 0.f;
#pragma unroll
                for (int bj = 0; bj < 2; ++bj) {
                    const int col = colb + bj * HALF; const size_t off = (size_t)row * D + col;
                    const u32x4 xw = *(const u32x4*)(XR + off);
                    f32x4 x0 = {bf_lo(xw.x), bf_hi(xw.x), bf_lo(xw.y), bf_hi(xw.y)}, x1 = {bf_lo(xw.z), bf_hi(xw.z), bf_lo(xw.w), bf_hi(xw.w)};
                    f32x4 v0 = acc[ai][bj][m][0], v1 = acc[ai][bj][m][1];
                    if (MODE == 0) { v0 = v0 * alpha; v1 = v1 * alpha; }
                    if (MODE == 1) { v0 = v0 * *(const f32x4*)(colscale + col); v1 = v1 * *(const f32x4*)(colscale + col + 4); }
                    if (MODE == 2) {
                        const u32x4 pw = *(const u32x4*)(pe + off);
                        const f32x4 p0 = {bf_lo(pw.x), bf_hi(pw.x), bf_lo(pw.y), bf_hi(pw.y)}, p1 = {bf_lo(pw.z), bf_hi(pw.z), bf_lo(pw.w), bf_hi(pw.w)};
#pragma unroll
                        for (int e = 0; e < 4; ++e) { v0[e] = fast_sigmoid(v0[e] * rinv) * p0[e]; v1[e] = fast_sigmoid(v1[e] * rinv) * p1[e]; }
                    }
                    x0 = x0 + v0; x1 = x1 + v1;
                    if (OUT) { *(f32x4*)(OUT + off) = x0; *(f32x4*)(OUT + off + 4) = x1; }
                    *(u32x4*)(XW + off) = pack8(x0, x1);
                    s2 += (x0[0] * x0[0] + x0[1] * x0[1]) + (x0[2] * x0[2] + x0[3] * x0[3]) + (x1[0] * x1[0] + x1[1] * x1[1]) + (x1[2] * x1[2] + x1[3] * x1[3]);
                }
                s2 += shx(s2, fq * 16 + fr, 16); s2 += shx(s2, fq * 16 + fr, 32);
                if (fq == 0) ss_add(ss_next, row, s2);
                asm volatile("" ::: "memory");
            }
    }
};
struct EpiQKV {
    const ss_t* ss; bf16_t* Q; const float* qg; const float* kg;
    __device__ __forceinline__ void operator()(const Acc& acc, const Unit& u, int wr, int wc, int fr, int fq) const {
        const int which = u.pn >> 2, pnl = u.pn & 3;
        bf16_t* dst = Q + (size_t)which * M * D;
        const int row0 = u.pm * BM + wr * 64 + fr, colb = pnl * 256 + wc * 64 + 8 * fq;
        const float* gp = which == 0 ? qg : kg;
        f32x4 gn[2][2];
#pragma unroll
        for (int bj = 0; bj < 2; ++bj)
#pragma unroll
            for (int n = 0; n < 2; ++n) gn[bj][n] = *(const f32x4*)(gp + 32 * bj + 8 * fq + 4 * n);
        const float qs = which == 0 ? 0.125f : 1.0f;
#pragma unroll
        for (int ai = 0; ai < 2; ++ai)
#pragma unroll
            for (int m = 0; m < 4; ++m) {
                const int row = row0 + ai * HALF + m * 16;
                const float rinv = ss_rinv(ss, row);
                f32x4 v[2][2]; float s2 = 0.f;
#pragma unroll
                for (int bj = 0; bj < 2; ++bj)
#pragma unroll
                    for (int n = 0; n < 2; ++n) { v[bj][n] = acc[ai][bj][m][n] * rinv; const f32x4 t = v[bj][n]; s2 += (t[0] * t[0] + t[1] * t[1]) + (t[2] * t[2] + t[3] * t[3]); }
                s2 += shx(s2, fq * 16 + fr, 16); s2 += shx(s2, fq * 16 + fr, 32);
                if (which < 2) {
                    const float hr = rsqrtf(s2 * (1.0f / HD) + EPS) * qs;
#pragma unroll
                    for (int bj = 0; bj < 2; ++bj)
#pragma unroll
                        for (int n = 0; n < 2; ++n) v[bj][n] = v[bj][n] * hr * gn[bj][n];
                }
#pragma unroll
                for (int bj = 0; bj < 2; ++bj) *(u32x4*)(dst + (size_t)row * D + colb + 32 * bj) = pack8(v[bj][0], v[bj][1]);
            }
    }
};
template <bool RINV> struct EpiBf16S {
    const ss_t* ss; bf16_t* O; int ldc;
    __device__ __forceinline__ void operator()(const Acc& acc, const Unit& u, int wr, int wc, int fr, int fq) const {
        const int row0 = u.pm * BM + wr * 64 + fr, colb = u.pn * BM + wc * 32 + 8 * fq;
#pragma unroll
        for (int ai = 0; ai < 2; ++ai)
#pragma unroll
            for (int m = 0; m < 4; ++m) {
                const int row = row0 + ai * HALF + m * 16;
                float rinv = 1.f; if (RINV) rinv = ss_rinv(ss, row);
#pragma unroll
                for (int bj = 0; bj < 2; ++bj) *(u32x4*)(O + (size_t)row * ldc + colb + bj * HALF) = pack8(acc[ai][bj][m][0] * rinv, acc[ai][bj][m][1] * rinv);
            }
    }
};

template <class Epi, bool ALIGN_EPI>
__device__ __forceinline__ void gemm_phase(LAS unsigned char* lds, const Gemm g, const StaticOrder& S, const Epi& E, int wv) {
    int tid_ = wv * 64 + lane_id(); asm volatile("" : "+v"(tid_));
    const int tid = tid_, wid = __builtin_amdgcn_readfirstlane(tid >> 6), lane = tid & 63, wr = wid >> 2, wc = wid & 3, fr = lane & 15, fq = lane >> 4;
    const int K = g.K, nt = K / BK;
    unsigned voffA[2], voffB[2];
#pragma unroll
    for (int i = 0; i < 2; ++i) { int R, C; stage_rc(tid * 16 + i * 8192, R, C); const int Rb = (R & ~31) + perm32(R & 31);
        voffA[i] = (unsigned)(R * g.lda + C) * 2u; voffB[i] = (unsigned)(Rb * g.ldb + C) * 2u; }
    const size_t kstep = (size_t)(BK * 2);
    const size_t hstepA = (size_t)HALF * g.lda * 2, hstepB = (size_t)HALF * g.ldb * 2;
    const size_t tstepA = 2 * hstepA, tstepB = 2 * hstepB;
    const unsigned ldsw = (unsigned)wid * 1024u;
    const int aoff = lds_byte(wr * 64 + fr, fq * 8), boff = lds_byte(wc * 32 + fr, fq * 8);
#define PG8_SA(b, h) (((b) * 2 + (h)) * HTB)
#define PG8_SB(b, h) ((4 + (b) * 2 + (h)) * HTB)
#define PG8_STAGE(bufoff, gbase, voff) do { _Pragma("unroll") for (int _i = 0; _i < 2; ++_i) \
        __builtin_amdgcn_global_load_lds((const unsigned*)((const char*)(gbase) + (voff)[_i]), (LAS unsigned*)(lds + (bufoff) + ldsw + _i * 8192), 16, 0, 0); } while (0)
#define PG8_LDA(dst, b, h) do { _Pragma("unroll") for (int m = 0; m < 4; ++m) _Pragma("unroll") for (int k = 0; k < 2; ++k) dst[m][k] = *(const LAS bf16x8*)(lds + PG8_SA(b, h) + aoff + m * 2048 + k * 1024); } while (0)
#define PG8_LDB(dst, b, h) do { _Pragma("unroll") for (int n = 0; n < 2; ++n) _Pragma("unroll") for (int k = 0; k < 2; ++k) dst[n][k] = *(const LAS bf16x8*)(lds + PG8_SB(b, h) + boff + n * 2048 + k * 1024); } while (0)
#define PG8_MMA(ai, bj, At, Bt) do { __builtin_amdgcn_s_setprio(1); _Pragma("unroll") for (int m = 0; m < 4; ++m) _Pragma("unroll") for (int n = 0; n < 2; ++n) _Pragma("unroll") for (int k = 0; k < 2; ++k) \
        acc[ai][bj][m][n] = __builtin_amdgcn_mfma_f32_16x16x32_bf16(Bt[n][k], At[m][k], acc[ai][bj][m][n], 0, 0, 0); __builtin_amdgcn_s_setprio(0); } while (0)
#define PG8_WAIT_V(n) asm volatile("s_waitcnt vmcnt(" #n ")" ::: "memory")
#define PG8_WAIT_L(n) asm volatile("s_waitcnt lgkmcnt(" #n ")" ::: "memory")
#define PG8_BAR __builtin_amdgcn_s_barrier()
#define PG8_SCHED __builtin_amdgcn_sched_barrier(0)
    Unit cur, nxt; int ui = 0;
    if (!S.next(0, cur)) return;
    Acc acc;
#pragma unroll
    for (int a = 0; a < 2; ++a)
#pragma unroll
        for (int b = 0; b < 2; ++b)
#pragma unroll
            for (int m = 0; m < 4; ++m)
#pragma unroll
                for (int n = 0; n < 2; ++n) acc[a][b][m][n] = (f32x4){0.f, 0.f, 0.f, 0.f};
    bf16x8 At[4][2], B0[2][2], B1[2][2];
    const char* cA = (const char*)g.A + (size_t)cur.pm * tstepA + (size_t)cur.pn * g.a_pn_off * 2; const char* cB = (const char*)g.Bt + (size_t)cur.pn * tstepB;
    PG8_STAGE(PG8_SB(0, 0), cB, voffB); PG8_STAGE(PG8_SB(0, 1), cB + hstepB, voffB); PG8_STAGE(PG8_SA(0, 0), cA, voffA); PG8_STAGE(PG8_SA(0, 1), cA + hstepA, voffA);
    if (wr == 1) PG8_BAR;
    PG8_WAIT_V(2); PG8_BAR;
    PG8_STAGE(PG8_SB(1, 0), cB + kstep, voffB); PG8_STAGE(PG8_SA(1, 0), cA + kstep, voffA); PG8_STAGE(PG8_SB(1, 1), cB + hstepB + kstep, voffB);
    PG8_WAIT_V(6); PG8_BAR;
    for (;;) {
        const bool has_next = S.next(ui + 1, nxt);
        const char* nA = has_next ? (const char*)g.A + (size_t)nxt.pm * tstepA + (size_t)nxt.pn * g.a_pn_off * 2 : cA; const char* nB = has_next ? (const char*)g.Bt + (size_t)nxt.pn * tstepB : cB;
        for (int t = 0; t < nt; t += 2) {
            const bool last = (t == nt - 2);
            const char* a1 = cA + (size_t)(t + 1) * kstep;
            const char* a2 = last ? nA : cA + (size_t)(t + 2) * kstep; const char* b2 = last ? nB : cB + (size_t)(t + 2) * kstep;
            const char* a3 = a2 + kstep; const char* b3 = b2 + kstep;
            PG8_LDB(B0, 0, 0); PG8_LDB(B1, 0, 1); PG8_SCHED; PG8_LDA(At, 0, 0); PG8_STAGE(PG8_SA(1, 1), a1 + hstepA, voffA);
            PG8_WAIT_V(8); PG8_WAIT_L(0); PG8_BAR; PG8_MMA(0, 0, At, B0); PG8_MMA(0, 1, At, B1); PG8_BAR; PG8_SCHED;
            PG8_LDA(At, 0, 1); PG8_STAGE(PG8_SB(0, 0), b2, voffB); PG8_STAGE(PG8_SB(0, 1), b2 + hstepB, voffB); PG8_STAGE(PG8_SA(0, 0), a2, voffA);
            PG8_WAIT_V(8); PG8_WAIT_L(0); PG8_BAR; PG8_MMA(1, 0, At, B0); PG8_MMA(1, 1, At, B1); PG8_BAR; PG8_SCHED;
            PG8_LDB(B0, 1, 0); PG8_LDB(B1, 1, 1); PG8_SCHED; PG8_LDA(At, 1, 0); PG8_STAGE(PG8_SA(0, 1), a2 + hstepA, voffA);
            PG8_WAIT_V(8); PG8_WAIT_L(0); PG8_BAR; PG8_MMA(0, 0, At, B0); PG8_MMA(0, 1, At, B1); PG8_BAR; PG8_SCHED;
            PG8_LDA(At, 1, 1); PG8_STAGE(PG8_SB(1, 0), b3, voffB); PG8_STAGE(PG8_SB(1, 1), b3 + hstepB, voffB); PG8_STAGE(PG8_SA(1, 0), a3, voffA);
            PG8_WAIT_V(8); PG8_WAIT_L(0); PG8_BAR; PG8_MMA(1, 0, At, B0); PG8_MMA(1, 1, At, B1); PG8_BAR; PG8_SCHED;
        }
        if constexpr (ALIGN_EPI) { if (wr == 0) PG8_BAR; }
        { const int l2 = lane_id(); E(acc, cur, wr, wc, l2 & 15, l2 >> 4); }
        if (!has_next) break;
#pragma unroll
        for (int a = 0; a < 2; ++a)
#pragma unroll
            for (int b = 0; b < 2; ++b)
#pragma unroll
                for (int m = 0; m < 4; ++m)
#pragma unroll
                    for (int n = 0; n < 2; ++n) acc[a][b][m][n] = (f32x4){0.f, 0.f, 0.f, 0.f};
        cur = nxt; cA = nA; cB = nB; ++ui;
        if constexpr (ALIGN_EPI) { if (wr == 1) PG8_BAR; }
    }
    PG8_WAIT_V(0);
    if constexpr (!ALIGN_EPI) { if (wr == 0) PG8_BAR; }
    PG8_BAR;
#undef PG8_SA
#undef PG8_SB
#undef PG8_STAGE
#undef PG8_LDA
#undef PG8_LDB
#undef PG8_MMA
#undef PG8_WAIT_V
#undef PG8_WAIT_L
#undef PG8_BAR
#undef PG8_SCHED
}
}

__device__ __forceinline__ unsigned f2bf(float f) { unsigned u = __builtin_bit_cast(unsigned, f); return (u + 0x7fffu + ((u >> 16) & 1u)) >> 16; }
__device__ __forceinline__ unsigned pk2(float lo, float hi) { return f2bf(lo) | (f2bf(hi) << 16); }
__device__ __forceinline__ float wave_sum(float v, int lane) {
#pragma unroll
    for (int o = 1; o < 64; o <<= 1) v += shx(v, lane, o);
    return v;
}
template <int MAP> __device__ __forceinline__ int map_row(int n0) {
    if (MAP == 1) { const int up = n0 >= DFF ? 1 : 0, j = n0 - up * DFF; return 256 * (j >> 7) + 128 * up + (j & 127); }
    if (MAP == 2) { const int pn = n0 >> 8, r = n0 & 255, wc = r >> 6, bj = (r >> 5) & 1; return 256 * pn + 128 * bj + 32 * wc; }
    return n0;
}
template <int MAP> __device__ __forceinline__ void conv_item(const float* W, int K, int N, bf16_t* WT, const float* gain, LAS float* scr, int item, int lane) {
    const int nblk = N / 64, kb = item / nblk, nb = item % nblk, k0 = 64 * kb, n0 = 64 * nb;
    const int c4 = lane & 15, kr = lane >> 4;
    f32x4 v[16];
#pragma unroll
    for (int i = 0; i < 16; ++i) v[i] = *(const f32x4*)(W + (size_t)(k0 + 4 * i + kr) * N + n0 + 4 * c4);
    if (gain) {
#pragma unroll
        for (int i = 0; i < 16; ++i) v[i] = v[i] * gain[k0 + 4 * i + kr];
    }
#pragma unroll
    for (int i = 0; i < 16; ++i) { const int kk = 4 * i + kr; LAS float* t = scr + (4 * c4) * 65 + kk; t[0] = v[i][0]; t[65] = v[i][1]; t[130] = v[i][2]; t[195] = v[i][3]; }
    asm volatile("s_waitcnt lgkmcnt(0)" ::: "memory");
    const int c = lane & 7, nr = lane >> 3;
#pragma unroll
    for (int j = 0; j < 8; ++j) { const int n = nr + 8 * j; const LAS float* t = scr + n * 65 + 8 * c;
        u32x4 o; o.x = pk2(t[0], t[1]); o.y = pk2(t[2], t[3]); o.z = pk2(t[4], t[5]); o.w = pk2(t[6], t[7]);
        const int r = map_row<MAP>(n0 + (n & 32)) + (n & 31);
        *(u32x4*)(WT + (size_t)r * K + k0 + 8 * c) = o; }
    asm volatile("s_waitcnt lgkmcnt(0)" ::: "memory");
}

__device__ __forceinline__ int lane_id() { int l; asm volatile("v_mbcnt_lo_u32_b32 %0, -1, 0\n\tv_mbcnt_hi_u32_b32 %0, -1, %0" : "=v"(l)); return l; }
__device__ __forceinline__ int opaque_int(int v) { asm volatile("" : "+s"(v)); return v; }
__device__ __forceinline__ unsigned char* opaque_ptr(unsigned char* p) { unsigned z = 0; asm volatile("" : "+s"(z)); return p + z; }
struct Args { const float* in[19]; float* out; unsigned char* ws; int ph_lo, ph_hi; };

template <int MAP> __device__ __forceinline__ void conv_mat(const float* W, int K, int N, bf16_t* WT, const float* gain, LAS float* scr, int gw, int NGW, int& off, int lane) {
    const int nitems = (K / 64) * (N / 64);
    int start = gw - off; if (start < 0) start += NGW;
    for (int it = start; it < nitems; it += NGW) conv_item<MAP>(W, K, N, WT, gain, scr, it, lane);
    off = (off + nitems) % NGW;
}

__device__ __forceinline__ void prologue(const Args& a, LAS unsigned char* lds, int G) {
    const int tid = threadIdx.x, lane = tid & 63, wave = tid >> 6;
    const int gw = blockIdx.x * 8 + wave, NGW = G * 8;
    unsigned char* ws = a.ws;
    if (blockIdx.x == 0) { unsigned* bw = (unsigned*)(ws + WS_BAR); for (int i = tid; i < 3456; i += 512) bw[i] = 0u; }
    { long long* ss = (long long*)(ws + WS_SS) + M; const int n4 = 16 * M / 2;
      for (int i = blockIdx.x * 512 + tid; i < n4; i += G * 512) ((f32x4*)ss)[i] = (f32x4){0.f, 0.f, 0.f, 0.f}; }
    { long long* ss0 = (long long*)(ws + WS_SS); bf16_t* xb = (bf16_t*)(ws + WS_XB);
      for (int m = gw; m < M; m += NGW) {
          const f32x4* xr = (const f32x4*)(a.in[0] + (size_t)m * D) + lane;
          u32x2* brow = (u32x2*)(xb + (size_t)m * D) + lane; float s = 0.f;
#pragma unroll
          for (int j = 0; j < 4; ++j) { const f32x4 v = xr[64 * j]; u32x2 w; w.x = pk2(v[0], v[1]); w.y = pk2(v[2], v[3]); brow[64 * j] = w; s += (v[0] * v[0] + v[1] * v[1]) + (v[2] * v[2] + v[3] * v[3]); }
          s = wave_sum(s, lane); if (lane == 0) ss0[m] = __float2ll_rn(s * 16777216.0f);
      } }
    { const f32x4* p4 = (const f32x4*)a.in[1]; u32x4* pb = (u32x4*)(ws + WS_PB); const int n8 = DEPTH * M * PLE / 8;
      for (int i = blockIdx.x * 512 + tid; i < n8; i += G * 512) { const f32x4 v0 = p4[2 * i], v1 = p4[2 * i + 1]; u32x4 w; w.x = pk2(v0[0], v0[1]); w.y = pk2(v0[2], v0[3]); w.z = pk2(v1[0], v1[1]); w.w = pk2(v1[2], v1[3]); pb[i] = w; } }
    LAS float* scr = (LAS float*)(lds + wave * 16640);
    int off = 0;
#pragma unroll 1
    for (int l = 0; l < DEPTH; ++l) {
        conv_mat<1>(a.in[3] + (size_t)l * D * 2 * DFF, D, 2 * DFF, (bf16_t*)(ws + WS_WGU + (size_t)(2 * l) * SZ_WGU), a.in[2] + l * D, scr, gw, NGW, off, lane);
        conv_mat<1>(a.in[14] + (size_t)l * D * 2 * DFF, D, 2 * DFF, (bf16_t*)(ws + WS_WGU + (size_t)(2 * l + 1) * SZ_WGU), a.in[13] + l * D, scr, gw, NGW, off, lane);
        conv_mat<0>(a.in[4] + (size_t)l * DFF * D, DFF, D, (bf16_t*)(ws + WS_WDN + (size_t)(2 * l) * SZ_WDN), nullptr, scr, gw, NGW, off, lane);
        conv_mat<0>(a.in[15] + (size_t)l * DFF * D, DFF, D, (bf16_t*)(ws + WS_WDN + (size_t)(2 * l + 1) * SZ_WDN), nullptr, scr, gw, NGW, off, lane);
        conv_mat<0>(a.in[17] + (size_t)l * D * D, D, D, (bf16_t*)(ws + WS_WGATE + (size_t)l * SZ_WDD), a.in[16] + l * D, scr, gw, NGW, off, lane);
        conv_mat<0>(a.in[18] + (size_t)l * PLE * D, PLE, D, (bf16_t*)(ws + WS_WPROJ + (size_t)l * SZ_WPROJ), nullptr, scr, gw, NGW, off, lane);
    }
#pragma unroll 1
    for (int j = 0; j < 2; ++j) {
        conv_mat<2>(a.in[6] + (size_t)j * D * 3 * D, D, 3 * D, (bf16_t*)(ws + WS_WQKV + (size_t)j * SZ_WQKV), a.in[5] + (2 * j) * D, scr, gw, NGW, off, lane);
        conv_mat<0>(a.in[9] + (size_t)j * D * D, D, D, (bf16_t*)(ws + WS_WO + (size_t)j * SZ_WDD), nullptr, scr, gw, NGW, off, lane);
        conv_mat<0>(a.in[10] + (size_t)j * D * D, D, D, (bf16_t*)(ws + WS_WIN + (size_t)j * SZ_WDD), a.in[5] + (2 * j + 1) * D, scr, gw, NGW, off, lane);
#pragma unroll 1
        for (int g = 0; g < 4; ++g)
            conv_mat<0>(a.in[11] + (size_t)(j * 4 + g) * 256 * 256, 256, 256, (bf16_t*)(ws + WS_WGRP + (size_t)j * SZ_WGRP + (size_t)g * 256 * 256 * 2), nullptr, scr, gw, NGW, off, lane);
    }
}

__device__ __forceinline__ void unpack8(const u32x4 w, float* f) {
    f[0] = pg8::bf_lo(w.x); f[1] = pg8::bf_hi(w.x); f[2] = pg8::bf_lo(w.y); f[3] = pg8::bf_hi(w.y); f[4] = pg8::bf_lo(w.z); f[5] = pg8::bf_hi(w.z); f[6] = pg8::bf_lo(w.w); f[7] = pg8::bf_hi(w.w);
}
__device__ __forceinline__ void pool_phase(const bf16_t* U, bf16_t* P, int G, int wv) {
    int tid_ = wv * 64 + lane_id(); asm volatile("" : "+v"(tid_));
    for (int item = blockIdx.x * 512 + tid_; item < (M / 16) * 128; item += G * 512) {
        const int chunk = item & 127, strip = item >> 7, row0 = strip * 16, t0 = row0 & (SEQ - 1);
        const int w = 2 << (chunk >> 5);
        const bf16_t* up = U + (size_t)row0 * D + chunk * 8; bf16_t* pp = P + (size_t)row0 * D + chunk * 8;
        float S[8];
#pragma unroll
        for (int e = 0; e < 8; ++e) S[e] = 0.f;
        for (int j = 1; j < w; ++j) if (t0 - j >= 0) { float f[8]; unpack8(*(const u32x4*)(up - (ptrdiff_t)j * D), f);
#pragma unroll
            for (int e = 0; e < 8; ++e) S[e] += f[e]; }
#pragma unroll 4
        for (int r = 0; r < 16; ++r) {
            const int t = t0 + r; float cur[8]; unpack8(*(const u32x4*)(up + (ptrdiff_t)r * D), cur);
            const float ic = 1.0f / (float)(t + 1 < w ? t + 1 : w); float o[8];
#pragma unroll
            for (int e = 0; e < 8; ++e) { S[e] += cur[e]; o[e] = S[e] * ic - cur[e]; }
            u32x4 ow; ow.x = pk2(o[0], o[1]); ow.y = pk2(o[2], o[3]); ow.z = pk2(o[4], o[5]); ow.w = pk2(o[6], o[7]);
            *(u32x4*)(pp + (ptrdiff_t)r * D) = ow;
            if (t - w + 1 >= 0) { float f[8]; unpack8(*(const u32x4*)(up + (ptrdiff_t)(r - w + 1) * D), f);
#pragma unroll
                for (int e = 0; e < 8; ++e) S[e] -= f[e]; }
        }
    }
}

__device__ __forceinline__ void attn_phase(LAS unsigned char* lds, const bf16_t* Q, const bf16_t* Kg, const bf16_t* Vg, bf16_t* O, int G, int wv) {
    LAS bf16_t* Ks = (LAS bf16_t*)lds;
    LAS bf16_t* Vt = (LAS bf16_t*)(lds + 9216);
    LAS unsigned* flags = (LAS unsigned*)(lds + 9216 + 8704);
    int tid_ = wv * 64 + lane_id(); asm volatile("" : "+v"(tid_));
    const int tid = tid_, wid = tid >> 6, lane = tid & 63, l16 = lane & 15, g = lane >> 4;
    for (int unit = blockIdx.x; unit < 2 * NH * (SEQ / 128); unit += G) {
        const int qblk = unit & 63, bh = unit >> 6, b = bh >> 4, h = bh & 15;
        const size_t rowbase = (size_t)b * SEQ; const int t0 = qblk * 128 + wid * 16, tq = t0 + l16;
        bf16x8 qf[2];
        { const bf16_t* qp = Q + (rowbase + tq) * D + h * HD + 8 * g; qf[0] = *(const bf16x8*)qp; qf[1] = *(const bf16x8*)(qp + 32); }
        f32x4 o[4];
#pragma unroll
        for (int i = 0; i < 4; ++i) o[i] = (f32x4){0.f, 0.f, 0.f, 0.f};
        float carry = 0.f; unsigned wave_done = 0u;
        const int key = tid >> 3, dc = tid & 7;
        const size_t srcb = (rowbase + key) * D + h * HD + 8 * dc;
        u32x4 kv, vv;
        { const size_t src = srcb + (size_t)(2 * qblk + 1) * 64 * D; kv = *(const u32x4*)(Kg + src); vv = *(const u32x4*)(Vg + src); }
        for (int kt = 2 * qblk + 1; kt >= 0; --kt) {
            if (lane == 0) flags[wid] = wave_done;
            __syncthreads();
            unsigned all = 1u;
#pragma unroll
            for (int i = 0; i < 8; ++i) all &= flags[i];
            if (all) break;
            { *(LAS u32x4*)(Ks + key * 72 + 8 * dc) = kv;
              LAS bf16_t* vd = Vt + (8 * dc) * 68 + key;
              vd[0 * 68] = (bf16_t)(vv.x & 0xffffu); vd[1 * 68] = (bf16_t)(vv.x >> 16); vd[2 * 68] = (bf16_t)(vv.y & 0xffffu); vd[3 * 68] = (bf16_t)(vv.y >> 16);
              vd[4 * 68] = (bf16_t)(vv.z & 0xffffu); vd[5 * 68] = (bf16_t)(vv.z >> 16); vd[6 * 68] = (bf16_t)(vv.w & 0xffffu); vd[7 * 68] = (bf16_t)(vv.w >> 16); }
            __syncthreads();
            if (kt > 0) { const size_t src = srcb + (size_t)(kt - 1) * 64 * D; kv = *(const u32x4*)(Kg + src); vv = *(const u32x4*)(Vg + src); }
            if (kt * 64 <= t0 + 14) {
                f32x4 z[4];
#pragma unroll
                for (int bb = 0; bb < 4; ++bb) { z[bb] = (f32x4){0.f, 0.f, 0.f, 0.f};
#pragma unroll
                    for (int ks = 0; ks < 2; ++ks) { const bf16x8 ka = *(const LAS bf16x8*)(Ks + (16 * bb + l16) * 72 + 32 * ks + 8 * g); z[bb] = __builtin_amdgcn_mfma_f32_16x16x32_bf16(ka, qf[ks], z[bb], 0, 0, 0); } }
                float sp[4][4], tot[4], Ex[4];
#pragma unroll
                for (int bb = 0; bb < 4; ++bb) {
                    float T = 0.f;
#pragma unroll
                    for (int i = 0; i < 4; ++i) { const int s = kt * 64 + 16 * bb + 4 * g + i; const float zz = z[bb][i];
                        const float v = fmaxf(zz, 0.f) + __logf(1.0f + __expf(-fabsf(zz))); sp[bb][i] = (s < tq) ? v : 0.f; T += sp[bb][i]; }
                    const float a_ = shx(T, lane, 16), b2 = T + a_, c_ = shx(b2, lane, 32);
                    tot[bb] = b2 + c_; Ex[bb] = ((g & 1) == 0 ? a_ : 0.f) + ((g & 2) == 0 ? c_ : 0.f);
                }
                float wv[4][4]; float right = 0.f;
#pragma unroll
                for (int bb = 3; bb >= 0; --bb) {
                    const float base = carry - right - Ex[bb]; float run = 0.f;
#pragma unroll
                    for (int i = 3; i >= 0; --i) { const int s = kt * 64 + 16 * bb + 4 * g + i; run += sp[bb][i]; const float F = base - run; wv[bb][i] = (s < tq) ? __expf(z[bb][i] + F) : 0.f; }
                    right += tot[bb];
                }
                carry -= right;
#pragma unroll
                for (int c = 0; c < 2; ++c) {
                    u32x4 pw; pw.x = pg8::cvt_pk_bf16(wv[2 * c][0], wv[2 * c][1]); pw.y = pg8::cvt_pk_bf16(wv[2 * c][2], wv[2 * c][3]);
                    pw.z = pg8::cvt_pk_bf16(wv[2 * c + 1][0], wv[2 * c + 1][1]); pw.w = pg8::cvt_pk_bf16(wv[2 * c + 1][2], wv[2 * c + 1][3]);
                    const bf16x8 pbf = __builtin_bit_cast(bf16x8, pw);
#pragma unroll
                    for (int db = 0; db < 4; ++db) {
                        const LAS bf16_t* vp = Vt + (16 * db + l16) * 68 + 32 * c + 4 * g;
                        const u32x2 v0 = *(const LAS u32x2*)vp, v1 = *(const LAS u32x2*)(vp + 16);
                        u32x4 va; va.x = v0.x; va.y = v0.y; va.z = v1.x; va.w = v1.y;
                        o[db] = __builtin_amdgcn_mfma_f32_16x16x32_bf16(__builtin_bit_cast(bf16x8, va), pbf, o[db], 0, 0, 0);
                    }
                }
                wave_done = (__builtin_amdgcn_ballot_w64(carry < -105.0f) == ~0ull) ? 1u : 0u;
            }
        }
        __syncthreads();
        { bf16_t* op = O + (rowbase + tq) * D + h * HD + 4 * g;
#pragma unroll
          for (int db = 0; db < 4; ++db) { u32x2 w; w.x = pg8::cvt_pk_bf16(o[db][0], o[db][1]); w.y = pg8::cvt_pk_bf16(o[db][2], o[db][3]); *(u32x2*)(op + 16 * db) = w; } }
    }
}

#define XB_TMO      128
#define XB_XCNT(j)  (256  + 64 * (j))
#define XB_XSUB(j)  (1280 + 64 * (j))
#define XB_XGEN(j)  (2304 + 64 * (j))
#define XB_TOP      3328
#define XB_TOPGEN   3392
#define XCD_BAR_WORDS 3456
#define XB_SPIN_CAP (1u << 18)
__device__ __forceinline__ unsigned xb_ld(unsigned* p)              { return __hip_atomic_load(p, __ATOMIC_RELAXED, __HIP_MEMORY_SCOPE_AGENT); }
__device__ __forceinline__ unsigned xb_add(unsigned* p, unsigned v) { return __hip_atomic_fetch_add(p, v, __ATOMIC_RELAXED, __HIP_MEMORY_SCOPE_AGENT); }
__device__ __forceinline__ unsigned xb_xcc_id() { return (unsigned)__builtin_amdgcn_s_getreg((3 << 11) | 20) & 0xFu; }
#define XB_SPIN(cond, bar) do { unsigned _sp = 0; while (cond) { __builtin_amdgcn_s_sleep(1); \
    if ((++_sp & 255u) == 0u) { if (xb_ld(&(bar)[XB_TMO])) break; if (_sp > XB_SPIN_CAP) { atomicAdd(&(bar)[XB_TMO], 1u); break; } } } } while (0)
struct XcdBarrier { unsigned* bar; unsigned x; volatile LAS unsigned* st; };
__device__ __forceinline__ XcdBarrier xcd_barrier_post(unsigned* bar, volatile LAS unsigned* st) {
    XcdBarrier b; b.bar = bar; b.x = xb_xcc_id(); b.st = st;
    if (threadIdx.x == 0) (void)xb_add(&bar[XB_XCNT(b.x)], 1u);
    return b;
}
__device__ __forceinline__ void xcd_barrier_complete(unsigned* bar, unsigned x, unsigned& nloc, unsigned& nx) {
    const unsigned G = gridDim.x * gridDim.y * gridDim.z;
    unsigned sum, cnt, mine, sp = 0u;
    for (;;) {
        sum = 0u; cnt = 0u; mine = 0u;
#pragma unroll
        for (unsigned j = 0; j < 16; ++j) { const unsigned c = xb_ld(&bar[XB_XCNT(j)]); sum += c; cnt += (c > 0u) ? 1u : 0u; mine = (j == x) ? c : mine; }
        if (sum == G) break;
        __builtin_amdgcn_s_sleep(1);
        if ((++sp & 255u) == 0u) { if (xb_ld(&bar[XB_TMO])) break; if (sp > XB_SPIN_CAP) { atomicAdd(&bar[XB_TMO], 1u); break; } }
    }
    nloc = mine > 0u ? mine : 1u; nx = cnt > 0u ? cnt : 1u;
}
__device__ __forceinline__ void xcd_barrier(const XcdBarrier& b, int wv) {
    asm volatile("s_waitcnt vmcnt(0)" ::: "memory");
    __syncthreads();
    if (opaque_int(wv) == 0) { if (lane_id() == 0) {
        unsigned* bar = (unsigned*)opaque_ptr((unsigned char*)b.bar);
        __builtin_amdgcn_s_waitcnt(0);
        unsigned nloc = b.st[0], nx = b.st[1];
        if (nloc == 0u) { xcd_barrier_complete(bar, b.x, nloc, nx); b.st[0] = nloc; b.st[1] = nx; }
        const unsigned old = xb_add(&bar[XB_XSUB(b.x)], 1u);
        const unsigned gen = old / nloc;
        if (old + 1u == (gen + 1u) * nloc) {
            __builtin_amdgcn_fence(__ATOMIC_RELEASE, "agent");
            asm volatile("s_waitcnt vmcnt(0)" ::: "memory");
            const unsigned og = xb_add(&bar[XB_TOP], 1u);
            const unsigned tg = og / nx;
            if (og + 1u == (tg + 1u) * nx) xb_add(&bar[XB_TOPGEN], 1u);
            else XB_SPIN(xb_ld(&bar[XB_TOPGEN]) == tg, bar);
            __builtin_amdgcn_fence(__ATOMIC_ACQUIRE, "agent");
            xb_add(&bar[XB_XGEN(b.x)], 1u);
            asm volatile("s_waitcnt vmcnt(0)" ::: "memory");
        } else {
            XB_SPIN(xb_ld(&bar[XB_XGEN(b.x)]) == gen, bar);
            __builtin_amdgcn_fence(__ATOMIC_ACQUIRE, "agent");
            asm volatile("s_waitcnt vmcnt(0)" ::: "memory");
        }
    } }
    __syncthreads();
}

__global__ void __launch_bounds__(512, 2) fwd_kernel(Args a) {
    extern __shared__ __attribute__((aligned(16))) unsigned char lds_raw[];
    LAS unsigned char* lds = (LAS unsigned char*)lds_raw;
    const int G0 = gridDim.x, bid0 = blockIdx.x, wv = __builtin_amdgcn_readfirstlane(threadIdx.x >> 6);
    unsigned char* ws0 = a.ws; float* X = a.out;
    volatile LAS unsigned* bst = (volatile LAS unsigned*)(lds + LDS_BYTES - 64);
    if (threadIdx.x < 2) bst[threadIdx.x] = 0u;
    __syncthreads();
    XcdBarrier xbar; xbar.bar = (unsigned*)(ws0 + WS_BAR); xbar.x = 0; xbar.st = bst;
#define REP(bit) _Pragma("unroll 1") for (int rep_ = 0, nrep_ = opaque_int((DUP_MASK & (bit)) ? 2 : 1); rep_ < nrep_; ++rep_)
#if MK_N_LAUNCHES == 1
#define IN(k) true
#define SEAM(k) do { xcd_barrier(xbar, wv); if (DUP_MASK & 2) xcd_barrier(xbar, wv); } while (0)
#define SEAM0() do { cg::this_grid().sync(); xbar = xcd_barrier_post((unsigned*)(ws0 + WS_BAR), bst); } while (0)
#else
    const int lo = a.ph_lo, hi = a.ph_hi;
#define IN(k) (lo <= (k) && (k) < hi)
#define SEAM(k) do { if (lo < (k) && (k) < hi) cg::this_grid().sync(); } while (0)
#define SEAM0() SEAM(1)
#endif
    if (IN(0)) { if (DBG_MASK & 1) { REP(1) { prologue(a, lds, G0); __syncthreads(); } } }
    SEAM0();
#pragma unroll 1
    for (int l = 0; l < DEPTH; ++l) {
        const int j = l >> 1, p0 = 1 + 8 * l; const bool is_attn = (l & 1) == 0;
        pg8::StaticOrder S;
#define OPQ() unsigned char* ws = opaque_ptr(ws0); const int G = opaque_int(G0), bid = opaque_int(bid0); pg8::ss_t* SS = (pg8::ss_t*)(ws + WS_SS); bf16_t* XB = (bf16_t*)(ws + ((l & 1) ? WS_XB2 : WS_XB)); bf16_t* XBN = (bf16_t*)(ws + ((l & 1) ? WS_XB : WS_XB2)); bf16_t* R1 = (bf16_t*)(ws + WS_R1); \
        bf16_t* ACT = R1; bf16_t* Qb = R1; bf16_t* Kb = R1 + (size_t)M * D; bf16_t* Vb = R1 + (size_t)2 * M * D; bf16_t* Ob = R1 + (size_t)3 * M * D; bf16_t* Ub = R1; bf16_t* PLb = R1 + (size_t)M * D; bf16_t* PE = (bf16_t*)(ws + WS_PE); \
        (void)SS; (void)XB; (void)XBN; (void)ACT; (void)Qb; (void)Kb; (void)Vb; (void)Ob; (void)Ub; (void)PLb; (void)PE; (void)G; (void)bid
#pragma unroll 1
        for (int f = 0; f < 2; ++f) {
            const int pa = p0 + 5 * f;
            if (pa != 1) SEAM(pa);
            if ((DBG_MASK & 2) && IN(pa)) {
                OPQ();
                pg8::Gemm g{XB, (const bf16_t*)(ws + WS_WGU + (size_t)(2 * l + f) * SZ_WGU), D, D, D, 0}; S.init(M, 2 * DFF, G, bid);
                pg8::EpiGU E{SS + (size_t)(4 * l + 2 * f) * M, ACT};
                REP(8) pg8::gemm_phase<pg8::EpiGU, true>(lds, g, S, E, wv);
            }
            SEAM(pa + 1);
            if ((DBG_MASK & 4) && IN(pa + 1)) {
                OPQ();
                pg8::Gemm g{ACT, (const bf16_t*)(ws + WS_WDN + (size_t)(2 * l + f) * SZ_WDN), DFF, DFF, DFF, 0}; S.init(M, D, G, bid);
                REP(256) { const bool dry = (DUP_MASK & 256) && rep_ == 0;
                pg8::EpiRes<0> E{XB, XB, nullptr, SS + (size_t)(dry ? 16 : 4 * l + 2 * f + 1) * M, dry ? 0.0f : 0.5f, nullptr, nullptr, nullptr};
                pg8::gemm_phase<pg8::EpiRes<0>, false>(lds, g, S, E, wv); }
            }
            if (f == 0) {
                SEAM(p0 + 2);
                if (IN(p0 + 2)) {
                    OPQ();
                    if (is_attn) { if (DBG_MASK & 8) {
                        pg8::Gemm g{XB, (const bf16_t*)(ws + WS_WQKV + (size_t)j * SZ_WQKV), D, D, D, 0}; S.init(M, 3 * D, G, bid);
                        pg8::EpiQKV E{SS + (size_t)(4 * l + 1) * M, Qb, a.in[7] + j * HD, a.in[8] + j * HD};
                        REP(32) pg8::gemm_phase<pg8::EpiQKV, true>(lds, g, S, E, wv);
                    } } else if (DBG_MASK & 16) {
                        pg8::Gemm g{XB, (const bf16_t*)(ws + WS_WIN + (size_t)j * SZ_WDD), D, D, D, 0}; S.init(M, D, G, bid);
                        pg8::EpiBf16S<true> E{SS + (size_t)(4 * l + 1) * M, Ub, D};
                        REP(64) pg8::gemm_phase<pg8::EpiBf16S<true>, false>(lds, g, S, E, wv);
                    }
                }
                SEAM(p0 + 3);
                if (IN(p0 + 3)) {
                    OPQ();
                    if (is_attn) { if (DBG_MASK & 32) { REP(4) attn_phase(lds, Qb, Kb, Vb, Ob, G, wv); } }
                    else if (DBG_MASK & 64) { REP(128) pool_phase(Ub, PLb, G, wv); }
                }
                SEAM(p0 + 4);
                if (IN(p0 + 4)) {
                    OPQ();
                    if (is_attn) { if (DBG_MASK & 128) {
                        pg8::Gemm g{Ob, (const bf16_t*)(ws + WS_WO + (size_t)j * SZ_WDD), D, D, D, 0}; S.init(M, D, G, bid);
                        REP(512) { const bool dry = (DUP_MASK & 512) && rep_ == 0;
                        pg8::EpiRes<0> E{XB, XB, nullptr, SS + (size_t)(dry ? 16 : 4 * l + 2) * M, dry ? 0.0f : 1.0f, nullptr, nullptr, nullptr};
                        pg8::gemm_phase<pg8::EpiRes<0>, false>(lds, g, S, E, wv); }
                    } } else if (DBG_MASK & 256) {
                        pg8::Gemm g{PLb, (const bf16_t*)(ws + WS_WGRP + (size_t)j * SZ_WGRP), D, 256, 256, 256}; S.init(M, D, G, bid);
                        pg8::EpiRes<1> E{XB, XB, nullptr, SS + (size_t)(4 * l + 2) * M, 1.0f, a.in[12] + j * D, nullptr, nullptr};
                        pg8::gemm_phase<pg8::EpiRes<1>, false>(lds, g, S, E, wv);
                    }
                }
            }
        }
        SEAM(p0 + 7);
        if ((DBG_MASK & 512) && IN(p0 + 7)) {
            OPQ();
            { pg8::Gemm g{(const bf16_t*)(ws + WS_PB) + (size_t)l * M * PLE, (const bf16_t*)(ws + WS_WPROJ + (size_t)l * SZ_WPROJ), PLE, PLE, PLE, 0}; S.init(M, D, G, bid);
              pg8::EpiBf16S<false> E{nullptr, PE, D};
              REP(16) pg8::gemm_phase<pg8::EpiBf16S<false>, false>(lds, g, S, E, wv); }
            { pg8::Gemm g{XB, (const bf16_t*)(ws + WS_WGATE + (size_t)l * SZ_WDD), D, D, D, 0}; S.init(M, D, G, bid);
              pg8::EpiRes<2> E{XB, XBN, l == DEPTH - 1 ? X : nullptr, SS + (size_t)(4 * l + 4) * M, 1.0f, nullptr, SS + (size_t)(4 * l + 3) * M, PE};
              pg8::gemm_phase<pg8::EpiRes<2>, false>(lds, g, S, E, wv); }
        }
    }
#undef IN
#undef SEAM
#undef SEAM0
#undef OPQ
}

extern "C" void kernel_launch(void* const* d_in, const int* in_sizes, int n_in, void* d_out, int out_size, void* d_ws, size_t ws_size, hipStream_t stream) {
    static int grid = 0;
    if (grid == 0) {
        if (n_in != 19 || out_size != M * D || ws_size < WS_END) { fprintf(stderr, "kernel_launch: unexpected shapes (n_in %d, out %d, ws %zu, need %zu)\n", n_in, out_size, ws_size, (size_t)WS_END); grid = -1; return; }
        int dev = 0, cus = 0, per_cu = 0;
        hipGetDevice(&dev); hipDeviceGetAttribute(&cus, hipDeviceAttributeMultiprocessorCount, dev);
        if (hipFuncSetAttribute((const void*)fwd_kernel, hipFuncAttributeMaxDynamicSharedMemorySize, LDS_BYTES) != hipSuccess) { fprintf(stderr, "kernel_launch: hipFuncSetAttribute failed\n"); }
        if (hipOccupancyMaxActiveBlocksPerMultiprocessor(&per_cu, (const void*)fwd_kernel, 512, LDS_BYTES) != hipSuccess || per_cu < 1) per_cu = 1;
        (void)hipGetLastError();
        grid = cus * per_cu;
        fprintf(stderr, "kernel_launch: grid %d (cus %d x %d)\n", grid, cus, per_cu);
    }
    if (grid < 0) return;
    Args a{};
    for (int i = 0; i < 19; ++i) a.in[i] = (const float*)d_in[i];
    a.out = (float*)d_out; a.ws = (unsigned char*)d_ws;
#if MK_N_LAUNCHES == 1
    a.ph_lo = 0; a.ph_hi = NPHASE;
    void* args[] = {&a};
    hipError_t e = hipLaunchCooperativeKernel((const void*)fwd_kernel, dim3(grid), dim3(512), args, LDS_BYTES, stream);
    if (e != hipSuccess) fprintf(stderr, "cooperative launch failed: %s (grid %d)\n", hipGetErrorString(e), grid);
#else
    for (int ph = 0; ph < NPHASE; ++ph) { a.ph_lo = ph; a.ph_hi = ph + 1; hipLaunchKernelGGL(fwd_kernel, dim3(grid), dim3(512), LDS_BYTES, stream, a); }
#endif
}
```

```cpp
#include <hip/hip_runtime.h>
#include <hip/hip_cooperative_groups.h>
#include <cstdio>
#include <cstdint>
namespace cg = cooperative_groups;

#define LAS __attribute__((address_space(3)))
typedef unsigned short bf16_t;
typedef short bf16x8 __attribute__((ext_vector_type(8)));
typedef short s16x4 __attribute__((ext_vector_type(4)));
typedef float f32x4 __attribute__((ext_vector_type(4)));
typedef float f32x2 __attribute__((ext_vector_type(2)));
typedef unsigned u32x4 __attribute__((ext_vector_type(4)));
typedef unsigned u32x2 __attribute__((ext_vector_type(2)));

__device__ __forceinline__ int lane_id();
__device__ __forceinline__ int opaque_int(int v);
__device__ __forceinline__ unsigned char* opaque_ptr(unsigned char* p);
__device__ __forceinline__ float shx(float v, int lane, int m) { return __builtin_bit_cast(float, __builtin_amdgcn_ds_bpermute((lane ^ m) << 2, __builtin_bit_cast(int, v))); }
#ifndef DUP_MASK
#define DUP_MASK 0
#endif

constexpr int D = 1024, M = 16384, SEQ = 8192, DEPTH = 4, NH = 16, HD = 64, DFF = 2816, PLE = 256;
constexpr float EPS = 1e-6f;
constexpr int NPHASE = 1 + 8 * DEPTH;

constexpr size_t SZ_SS = (size_t)17 * M * 4;
constexpr size_t SZ_WGU = (size_t)2 * DFF * D * 2, SZ_WDN = (size_t)D * DFF * 2, SZ_WQKV = (size_t)3 * D * D * 2, SZ_WDD = (size_t)D * D * 2, SZ_WGRP = (size_t)4 * 256 * 256 * 2, SZ_WPROJ = (size_t)D * PLE * 2;
constexpr size_t WS_SS = 0;
constexpr size_t WS_BAR = 0x300000;
constexpr size_t WS_WGU = 4u << 20;
constexpr size_t WS_WDN = WS_WGU + 8 * SZ_WGU;
constexpr size_t WS_WQKV = WS_WDN + 8 * SZ_WDN;
constexpr size_t WS_WO = WS_WQKV + 2 * SZ_WQKV;
constexpr size_t WS_WIN = WS_WO + 2 * SZ_WDD;
constexpr size_t WS_WGRP = WS_WIN + 2 * SZ_WDD;
constexpr size_t WS_WGATE = WS_WGRP + 2 * SZ_WGRP;
constexpr size_t WS_WPROJ = WS_WGATE + 4 * SZ_WDD;
constexpr size_t WS_XB = WS_WPROJ + 4 * SZ_WPROJ;
constexpr size_t SZ_MD = (size_t)M * D * 2;
constexpr size_t WS_R1 = WS_XB + SZ_MD;
constexpr size_t WS_PB = WS_R1 + 4 * SZ_MD;
constexpr size_t WS_PE = WS_PB + SZ_MD;
constexpr size_t WS_XB2 = WS_PE + SZ_MD;
constexpr size_t WS_END = WS_XB2 + SZ_MD;
static_assert(SZ_SS <= WS_BAR && WS_BAR + 16384 <= WS_WGU && (size_t)M * DFF * 2 <= 4 * SZ_MD, "ws map");

constexpr int LDS_BYTES = 8 * 16640 + 256;

namespace pg8 {
constexpr int BM = 256, BK = 64, HALF = 128, HTB = HALF * BK * 2, STAGE_BYTES = 8 * HTB, NXCD = 8, WGM = 8;
__host__ __device__ __forceinline__ int lds_byte(int r, int c) { const int st = (r >> 4) * 2 + (c >> 5), rr = r & 15, cc = c & 31, ob = rr * 64 + cc * 2; return st * 1024 + (ob ^ (((ob >> 9) & 1) << 5)); }
__host__ __device__ __forceinline__ void stage_rc(int b, int& R, int& C) { const int st = b / 1024, sb = b % 1024, swz = sb ^ (((sb >> 9) & 1) << 5); R = (st >> 1) * 16 + swz / 64; C = (st & 1) * 32 + (swz % 64) / 2; }
__host__ __device__ __forceinline__ int perm32(int rho) { const int n = rho >> 4, i = rho & 15; return 8 * (i >> 2) + 4 * n + (i & 3); }

struct Unit { int pm, pn; };
struct Gemm { const bf16_t* A; const bf16_t* Bt; int lda, ldb, K; int a_pn_off; int stagger; int epi_rep; int umask = -1; };

struct StaticOrder {
    int nM, nN, nwg, G, c;
    __device__ void init(int M_, int N_, int G_, int c_) { nM = M_ / BM; nN = N_ / BM; nwg = nM * nN; G = G_; c = c_; }
    __device__ bool next(int i, Unit& u) const {
        const int L = i * G + c; if (L >= nwg) return false;
        int wgid = L; { const int q = nwg / NXCD, r = nwg % NXCD, xcd = wgid % NXCD, off = wgid / NXCD; wgid = (xcd < r ? xcd * (q + 1) : r * (q + 1) + (xcd - r) * q) + off; }
        const int nig = WGM * nN, gid = wgid / nig, fm = gid * WGM, gsz = (nM - fm) < WGM ? (nM - fm) : WGM;
        u.pm = fm + ((wgid % nig) % gsz); u.pn = (wgid % nig) / gsz; return true;
    }
};

__device__ __forceinline__ unsigned cvt_pk_bf16(float lo, float hi) { unsigned r; asm volatile("v_cvt_pk_bf16_f32 %0, %1, %2" : "=v"(r) : "v"(lo), "v"(hi)); return r; }
__device__ __forceinline__ u32x4 pack8(const f32x4 a, const f32x4 b) { u32x4 w; w.x = cvt_pk_bf16(a[0], a[1]); w.y = cvt_pk_bf16(a[2], a[3]); w.z = cvt_pk_bf16(b[0], b[1]); w.w = cvt_pk_bf16(b[2], b[3]); return w; }
__device__ __forceinline__ float bf_lo(unsigned w) { return __uint_as_float(w << 16); }
__device__ __forceinline__ float bf_hi(unsigned w) { return __uint_as_float(w & 0xffff0000u); }
__device__ __forceinline__ float fast_sigmoid(float v) { return __builtin_amdgcn_rcpf(1.0f + __expf(-v)); }

typedef f32x4 Acc[2][2][4][2];
typedef unsigned ss_t;
constexpr float SS_SCALE = 2048.0f;
__device__ __forceinline__ float ss_rinv_v(ss_t v) { return rsqrtf((float)v * (1.0f / (SS_SCALE * D)) + EPS); }
__device__ __forceinline__ void ss_pre(ss_t (&pv)[8], const ss_t* ss, const Unit& u, int wr, int fr) {
#pragma unroll
    for (int ai = 0; ai < 2; ++ai)
#pragma unroll
        for (int m = 0; m < 4; ++m) pv[ai * 4 + m] = ss[u.pm * BM + wr * 64 + fr + ai * HALF + m * 16];
}
__device__ __forceinline__ void ss_add(ss_t* ss, int row, float s2) { (void)__hip_atomic_fetch_add(ss + row, (unsigned)__float2uint_rn(s2 * SS_SCALE), __ATOMIC_RELAXED, __HIP_MEMORY_SCOPE_AGENT); }

struct EpiGU {
    const ss_t* ss; bf16_t* act;
    __device__ __forceinline__ void pre(ss_t (&pv)[8], const Unit& u, int wr, int fr) const { ss_pre(pv, ss, u, wr, fr); }
    __device__ __forceinline__ void operator()(const Acc& acc, const Unit& u, int wr, int wc, int fr, int fq, const ss_t (&pv)[8]) const {
        const int row0 = u.pm * BM + wr * 64 + fr, col = u.pn * 128 + wc * 32 + 8 * fq;
#pragma unroll
        for (int ai = 0; ai < 2; ++ai)
#pragma unroll
            for (int m = 0; m < 4; ++m) {
                const int row = row0 + ai * HALF + m * 16;
                const float rinv = ss_rinv_v(pv[ai * 4 + m]);
                f32x4 o[2];
#pragma unroll
                for (int n = 0; n < 2; ++n) {
#pragma unroll
                    for (int h = 0; h < 2; ++h) {
                        const f32x2 g = (f32x2){acc[ai][0][m][n][2 * h], acc[ai][0][m][n][2 * h + 1]} * rinv, up = (f32x2){acc[ai][1][m][n][2 * h], acc[ai][1][m][n][2 * h + 1]} * rinv;
                        const f32x2 t = g * (-1.44269504089f);
                        f32x2 e; e.x = __builtin_amdgcn_exp2f(t.x); e.y = __builtin_amdgcn_exp2f(t.y);
                        const f32x2 d = e + 1.0f;
                        f32x2 r; r.x = __builtin_amdgcn_rcpf(d.x); r.y = __builtin_amdgcn_rcpf(d.y);
                        const f32x2 v = (g * r) * up;
                        o[n][2 * h] = v.x; o[n][2 * h + 1] = v.y;
                    }
                }
                *(u32x4*)(act + (size_t)row * DFF + col) = pack8(o[0], o[1]);
            }
    }
};
template <int MODE> struct EpiRes {
    const bf16_t* XR; bf16_t* XW; float* OUT; ss_t* ss_next; float alpha; const float* colscale; const ss_t* ss_cur; const bf16_t* pe;
    __device__ __forceinline__ void pre(ss_t (&pv)[8], const Unit& u, int wr, int fr) const { if (MODE == 2) ss_pre(pv, ss_cur, u, wr, fr); }
    __device__ __forceinline__ void operator()(const Acc& acc, const Unit& u, int wr, int wc, int fr, int fq, const ss_t (&pv)[8]) const {
        const int row0 = u.pm * BM + wr * 64 + fr, colb = u.pn * BM + wc * 32 + 8 * fq;
        f32x4 cs[2][2];
        if (MODE == 1) {
#pragma unroll
            for (int bj = 0; bj < 2; ++bj) { cs[bj][0] = *(const f32x4*)(colscale + colb + bj * HALF); cs[bj][1] = *(const f32x4*)(colscale + colb + bj * HALF + 4); }
        }
#pragma unroll
        for (int ai = 0; ai < 2; ++ai) {
            u32x4 xw[4][2], pw[4][2]; float rinv[4];
#pragma unroll
            for (int m = 0; m < 4; ++m) {
                const int row = row0 + ai * HALF + m * 16;
#pragma unroll
                for (int bj = 0; bj < 2; ++bj) { const size_t off = (size_t)row * D + colb + bj * HALF; xw[m][bj] = *(const u32x4*)(XR + off); if (MODE == 2) pw[m][bj] = *(const u32x4*)(pe + off); }
                rinv[m] = 1.f; if (MODE == 2) rinv[m] = ss_rinv_v(pv[ai * 4 + m]);
            }
#pragma unroll
            for (int m = 0; m < 4; ++m) {
                const int row = row0 + ai * HALF + m * 16;
                float s2 = 0.f;
#pragma unroll
                for (int bj = 0; bj < 2; ++bj) {
                    const size_t off = (size_t)row * D + colb + bj * HALF;
                    const u32x4 xq = xw[m][bj];
                    f32x4 x0 = {bf_lo(xq.x), bf_hi(xq.x), bf_lo(xq.y), bf_hi(xq.y)}, x1 = {bf_lo(xq.z), bf_hi(xq.z), bf_lo(xq.w), bf_hi(xq.w)};
                    f32x4 v0 = acc[ai][bj][m][0], v1 = acc[ai][bj][m][1];
                    if (MODE == 0) { v0 = v0 * alpha; v1 = v1 * alpha; }
                    if (MODE == 1) { v0 = v0 * cs[bj][0]; v1 = v1 * cs[bj][1]; }
                    if (MODE == 2) {
                        const u32x4 pq = pw[m][bj];
                        const f32x4 p0 = {bf_lo(pq.x), bf_hi(pq.x), bf_lo(pq.y), bf_hi(pq.y)}, p1 = {bf_lo(pq.z), bf_hi(pq.z), bf_lo(pq.w), bf_hi(pq.w)};
#pragma unroll
                        for (int e = 0; e < 4; ++e) { v0[e] = fast_sigmoid(v0[e] * rinv[m]) * p0[e]; v1[e] = fast_sigmoid(v1[e] * rinv[m]) * p1[e]; }
                    }
                    x0 = x0 + v0; x1 = x1 + v1;
                    if (OUT) { *(f32x4*)(OUT + off) = x0; *(f32x4*)(OUT + off + 4) = x1; }
                    *(u32x4*)(XW + off) = pack8(x0, x1);
                    s2 += (x0[0] * x0[0] + x0[1] * x0[1]) + (x0[2] * x0[2] + x0[3] * x0[3]) + (x1[0] * x1[0] + x1[1] * x1[1]) + (x1[2] * x1[2] + x1[3] * x1[3]);
                }
                s2 += shx(s2, fq * 16 + fr, 16); s2 += shx(s2, fq * 16 + fr, 32);
                if (fq == 0) ss_add(ss_next, row, s2);
            }
            asm volatile("" ::: "memory");
        }
    }
};
struct EpiNull {
    __device__ __forceinline__ void pre(ss_t (&pv)[8], const Unit& u, int wr, int fr) const {}
    __device__ __forceinline__ void operator()(const Acc& acc, const Unit& u, int wr, int wc, int fr, int fq, const ss_t (&pv)[8]) const {
#pragma unroll
        for (int a = 0; a < 2; ++a)
#pragma unroll
            for (int b = 0; b < 2; ++b)
#pragma unroll
                for (int m = 0; m < 4; ++m)
#pragma unroll
                    for (int n = 0; n < 2; ++n) asm volatile("" :: "v"(acc[a][b][m][n]));
    }
};
struct EpiQKV {
    const ss_t* ss; bf16_t* Q; const float* qg; const float* kg;
    __device__ __forceinline__ void pre(ss_t (&pv)[8], const Unit& u, int wr, int fr) const { ss_pre(pv, ss, u, wr, fr); }
    __device__ __forceinline__ void operator()(const Acc& acc, const Unit& u, int wr, int wc, int fr, int fq, const ss_t (&pv)[8]) const {
        const int which = u.pn >> 2, pnl = u.pn & 3;
        bf16_t* dst = Q + (size_t)which * M * D;
        const int row0 = u.pm * BM + wr * 64 + fr, colb = pnl * 256 + wc * 64 + 8 * fq;
        const float* gp = which == 0 ? qg : kg;
        f32x4 gn[2][2];
#pragma unroll
        for (int bj = 0; bj < 2; ++bj)
#pragma unroll
            for (int n = 0; n < 2; ++n) gn[bj][n] = *(const f32x4*)(gp + 32 * bj + 8 * fq + 4 * n);
        const float qs = which == 0 ? 0.125f : 1.0f;
#pragma unroll
        for (int ai = 0; ai < 2; ++ai)
#pragma unroll
            for (int m = 0; m < 4; ++m) {
                const int row = row0 + ai * HALF + m * 16;
                const float rinv = ss_rinv_v(pv[ai * 4 + m]);
                f32x4 v[2][2]; float s2 = 0.f;
#pragma unroll
                for (int bj = 0; bj < 2; ++bj)
#pragma unroll
                    for (int n = 0; n < 2; ++n) { v[bj][n] = acc[ai][bj][m][n] * rinv; const f32x4 t = v[bj][n]; s2 += (t[0] * t[0] + t[1] * t[1]) + (t[2] * t[2] + t[3] * t[3]); }
                s2 += shx(s2, fq * 16 + fr, 16); s2 += shx(s2, fq * 16 + fr, 32);
                if (which < 2) {
                    const float hr = rsqrtf(s2 * (1.0f / HD) + EPS) * qs;
#pragma unroll
                    for (int bj = 0; bj < 2; ++bj)
#pragma unroll
                        for (int n = 0; n < 2; ++n) v[bj][n] = v[bj][n] * hr * gn[bj][n];
                }
#pragma unroll
                for (int bj = 0; bj < 2; ++bj) *(u32x4*)(dst + (size_t)row * D + colb + 32 * bj) = pack8(v[bj][0], v[bj][1]);
            }
    }
};
template <bool RINV> struct EpiBf16S {
    const ss_t* ss; bf16_t* O; int ldc;
    __device__ __forceinline__ void pre(ss_t (&pv)[8], const Unit& u, int wr, int fr) const { if (RINV) ss_pre(pv, ss, u, wr, fr); }
    __device__ __forceinline__ void operator()(const Acc& acc, const Unit& u, int wr, int wc, int fr, int fq, const ss_t (&pv)[8]) const {
        const int row0 = u.pm * BM + wr * 64 + fr, colb = u.pn * BM + wc * 32 + 8 * fq;
#pragma unroll
        for (int ai = 0; ai < 2; ++ai)
#pragma unroll
            for (int m = 0; m < 4; ++m) {
                const int row = row0 + ai * HALF + m * 16;
                float rinv = 1.f; if (RINV) rinv = ss_rinv_v(pv[ai * 4 + m]);
#pragma unroll
                for (int bj = 0; bj < 2; ++bj) *(u32x4*)(O + (size_t)row * ldc + colb + bj * HALF) = pack8(acc[ai][bj][m][0] * rinv, acc[ai][bj][m][1] * rinv);
            }
    }
};

__device__ __forceinline__ void gemm_prefetch_b(LAS unsigned char* lds, const Gemm g, const StaticOrder& S, int wv) {
    int tid_ = wv * 64 + lane_id(); asm volatile("" : "+v"(tid_));
    const int tid = tid_, wid = __builtin_amdgcn_readfirstlane(tid >> 6);
    Unit cur; if (!S.next(0, cur)) return;
    const size_t hstepB = (size_t)HALF * g.ldb * 2; const char* cB = (const char*)g.Bt + (size_t)cur.pn * 2 * hstepB;
    const unsigned ldsw = (unsigned)wid * 1024u;
#pragma unroll
    for (int i = 0; i < 2; ++i) { int R, C; stage_rc(tid * 16 + i * 8192, R, C); const int Rb = (R & ~31) + perm32(R & 31); const unsigned vo = (unsigned)(Rb * g.ldb + C) * 2u;
#pragma unroll
        for (int b = 0; b < 2; ++b)
#pragma unroll
            for (int h = 0; h < 2; ++h)
                __builtin_amdgcn_global_load_lds((const unsigned*)(cB + (size_t)h * hstepB + (size_t)b * (BK * 2) + vo), (LAS unsigned*)(lds + (4 + b * 2 + h) * HTB + ldsw + i * 8192), 16, 0, 0);
    }
}

template <class Epi, bool ALIGN_EPI, bool BPRE = false>
__device__ __forceinline__ void gemm_phase(LAS unsigned char* lds, const Gemm g, const StaticOrder& S, const Epi& E, int wv) {
    int tid_ = wv * 64 + lane_id(); asm volatile("" : "+v"(tid_));
    const int tid = tid_, wid = __builtin_amdgcn_readfirstlane(tid >> 6), lane = tid & 63, wr = wid >> 2, wc = wid & 3, fr = lane & 15, fq = lane >> 4;
    const int K = g.K, nt = K / BK;
    unsigned voffA[2], voffB[2];
#pragma unroll
    for (int i = 0; i < 2; ++i) { int R, C; stage_rc(tid * 16 + i * 8192, R, C); const int Rb = (R & ~31) + perm32(R & 31);
        voffA[i] = (unsigned)(R * g.lda + C) * 2u; voffB[i] = (unsigned)(Rb * g.ldb + C) * 2u; }
    const size_t kstep = (size_t)(BK * 2);
    const size_t hstepA = (size_t)HALF * g.lda * 2, hstepB = (size_t)HALF * g.ldb * 2;
    const size_t tstepA = 2 * hstepA, tstepB = 2 * hstepB;
    const unsigned ldsw = (unsigned)wid * 1024u;
    const int aoff = lds_byte(wr * 64 + fr, fq * 8), boff = lds_byte(wc * 32 + fr, fq * 8);
#define PG8_SA(b, h) (((b) * 2 + (h)) * HTB)
#define PG8_SB(b, h) ((4 + (b) * 2 + (h)) * HTB)
#define PG8_STAGE(bufoff, gbase, voff) do { _Pragma("unroll") for (int _i = 0; _i < 2; ++_i) \
        __builtin_amdgcn_global_load_lds((const unsigned*)((const char*)(gbase) + (voff)[_i]), (LAS unsigned*)(lds + (bufoff) + ldsw + _i * 8192), 16, 0, 0); } while (0)
#define PG8_LDA(dst, b, h) do { _Pragma("unroll") for (int m = 0; m < 4; ++m) _Pragma("unroll") for (int k = 0; k < 2; ++k) dst[m][k] = *(const LAS bf16x8*)(lds + PG8_SA(b, h) + aoff + m * 2048 + k * 1024); } while (0)
#define PG8_LDB(dst, b, h) do { _Pragma("unroll") for (int n = 0; n < 2; ++n) _Pragma("unroll") for (int k = 0; k < 2; ++k) dst[n][k] = *(const LAS bf16x8*)(lds + PG8_SB(b, h) + boff + n * 2048 + k * 1024); } while (0)
#define PG8_MMA(ai, bj, At, Bt) do { __builtin_amdgcn_s_setprio(1); _Pragma("unroll") for (int m = 0; m < 4; ++m) _Pragma("unroll") for (int n = 0; n < 2; ++n) _Pragma("unroll") for (int k = 0; k < 2; ++k) \
        acc[ai][bj][m][n] = __builtin_amdgcn_mfma_f32_16x16x32_bf16(Bt[n][k], At[m][k], acc[ai][bj][m][n], 0, 0, 0); __builtin_amdgcn_s_setprio(0); } while (0)
#define PG8_WAIT_V(n) asm volatile("s_waitcnt vmcnt(" #n ")" ::: "memory")
#define PG8_WAIT_L(n) asm volatile("s_waitcnt lgkmcnt(" #n ")" ::: "memory")
#define PG8_BAR __builtin_amdgcn_s_barrier()
#define PG8_SCHED __builtin_amdgcn_sched_barrier(0)
    Unit cur, nxt; int ui = 0;
    if (!S.next(0, cur)) return;
    if (g.stagger > 0 && (S.nwg - S.c + S.G - 1) / S.G < (S.nwg + S.G - 1) / S.G) { const unsigned long long t0 = __builtin_amdgcn_s_memrealtime(); while (__builtin_amdgcn_s_memrealtime() - t0 < (unsigned long long)g.stagger) __builtin_amdgcn_s_sleep(16); }
    Acc acc;
#pragma unroll
    for (int a = 0; a < 2; ++a)
#pragma unroll
        for (int b = 0; b < 2; ++b)
#pragma unroll
            for (int m = 0; m < 4; ++m)
#pragma unroll
                for (int n = 0; n < 2; ++n) acc[a][b][m][n] = (f32x4){0.f, 0.f, 0.f, 0.f};
    bf16x8 At[4][2], B0[2][2], B1[2][2];
    ss_t pv[8];
#pragma unroll
    for (int i = 0; i < 8; ++i) pv[i] = 0;
    const char* cA = (const char*)g.A + (size_t)(cur.pm & g.umask) * tstepA + (size_t)(cur.pn & g.umask) * g.a_pn_off * 2; const char* cB = (const char*)g.Bt + (size_t)(cur.pn & g.umask) * tstepB;
    if constexpr (BPRE) {
        PG8_STAGE(PG8_SA(0, 0), cA, voffA); PG8_STAGE(PG8_SA(0, 1), cA + hstepA, voffA);
        if (wr == 1) PG8_BAR;
        PG8_WAIT_V(2); PG8_BAR;
        PG8_STAGE(PG8_SA(1, 0), cA + kstep, voffA);
        PG8_WAIT_V(2); PG8_BAR;
    } else {
    PG8_STAGE(PG8_SB(0, 0), cB, voffB); PG8_STAGE(PG8_SB(0, 1), cB + hstepB, voffB); PG8_STAGE(PG8_SA(0, 0), cA, voffA); PG8_STAGE(PG8_SA(0, 1), cA + hstepA, voffA);
    if (wr == 1) PG8_BAR;
    PG8_WAIT_V(2); PG8_BAR;
    PG8_STAGE(PG8_SB(1, 0), cB + kstep, voffB); PG8_STAGE(PG8_SA(1, 0), cA + kstep, voffA); PG8_STAGE(PG8_SB(1, 1), cB + hstepB + kstep, voffB);
    PG8_WAIT_V(6); PG8_BAR;
    }
    for (;;) {
        const bool has_next = S.next(ui + 1, nxt);
        const char* nA = has_next ? (const char*)g.A + (size_t)(nxt.pm & g.umask) * tstepA + (size_t)(nxt.pn & g.umask) * g.a_pn_off * 2 : cA; const char* nB = has_next ? (const char*)g.Bt + (size_t)(nxt.pn & g.umask) * tstepB : cB;
        for (int t = 0; t < nt; t += 2) {
            const bool last = (t == nt - 2);
            if (last) E.pre(pv, cur, wr, lane_id() & 15);
            const char* a1 = cA + (size_t)(t + 1) * kstep;
            const char* a2 = last ? nA : cA + (size_t)(t + 2) * kstep; const char* b2 = last ? nB : cB + (size_t)(t + 2) * kstep;
            const char* a3 = a2 + kstep; const char* b3 = b2 + kstep;
            PG8_LDB(B0, 0, 0); PG8_LDB(B1, 0, 1); PG8_SCHED; PG8_LDA(At, 0, 0); PG8_STAGE(PG8_SA(1, 1), a1 + hstepA, voffA);
            PG8_WAIT_V(8); PG8_WAIT_L(0); PG8_BAR; PG8_MMA(0, 0, At, B0); PG8_MMA(0, 1, At, B1); PG8_BAR; PG8_SCHED;
            PG8_LDA(At, 0, 1); PG8_STAGE(PG8_SB(0, 0), b2, voffB); PG8_STAGE(PG8_SB(0, 1), b2 + hstepB, voffB); PG8_STAGE(PG8_SA(0, 0), a2, voffA);
            PG8_WAIT_V(8); PG8_WAIT_L(0); PG8_BAR; PG8_MMA(1, 0, At, B0); PG8_MMA(1, 1, At, B1); PG8_BAR; PG8_SCHED;
            PG8_LDB(B0, 1, 0); PG8_LDB(B1, 1, 1); PG8_SCHED; PG8_LDA(At, 1, 0); PG8_STAGE(PG8_SA(0, 1), a2 + hstepA, voffA);
            PG8_WAIT_V(8); PG8_WAIT_L(0); PG8_BAR; PG8_MMA(0, 0, At, B0); PG8_MMA(0, 1, At, B1); PG8_BAR; PG8_SCHED;
            PG8_LDA(At, 1, 1); PG8_STAGE(PG8_SB(1, 0), b3, voffB); PG8_STAGE(PG8_SB(1, 1), b3 + hstepB, voffB); PG8_STAGE(PG8_SA(1, 0), a3, voffA);
            PG8_WAIT_V(8); PG8_WAIT_L(0); PG8_BAR; PG8_MMA(1, 0, At, B0); PG8_MMA(1, 1, At, B1); PG8_BAR; PG8_SCHED;
        }
        if constexpr (ALIGN_EPI) { if (wr == 0) PG8_BAR; }
        _Pragma("unroll 1") for (int er_ = 0; er_ < g.epi_rep; ++er_) { const int l2 = lane_id(); E(acc, cur, wr, wc, l2 & 15, l2 >> 4, pv); }
        if (!has_next) break;
#pragma unroll
        for (int a = 0; a < 2; ++a)
#pragma unroll
            for (int b = 0; b < 2; ++b)
#pragma unroll
                for (int m = 0; m < 4; ++m)
#pragma unroll
                    for (int n = 0; n < 2; ++n) acc[a][b][m][n] = (f32x4){0.f, 0.f, 0.f, 0.f};
        cur = nxt; cA = nA; cB = nB; ++ui;
        if constexpr (ALIGN_EPI) { if (wr == 1) PG8_BAR; }
    }
    PG8_WAIT_V(0);
    if constexpr (!ALIGN_EPI) { if (wr == 0) PG8_BAR; }
    PG8_BAR;
#undef PG8_SA
#undef PG8_SB
#undef PG8_STAGE
#undef PG8_LDA
#undef PG8_LDB
#undef PG8_MMA
#undef PG8_WAIT_V
#undef PG8_WAIT_L
#undef PG8_BAR
#undef PG8_SCHED
}
}

__device__ __forceinline__ unsigned f2bf(float f) { unsigned u = __builtin_bit_cast(unsigned, f); return (u + 0x7fffu + ((u >> 16) & 1u)) >> 16; }
__device__ __forceinline__ unsigned pk2(float lo, float hi) { return f2bf(lo) | (f2bf(hi) << 16); }
__device__ __forceinline__ float wave_sum(float v, int lane) {
#pragma unroll
    for (int o = 1; o < 64; o <<= 1) v += shx(v, lane, o);
    return v;
}
template <int MAP> __device__ __forceinline__ int map_row(int n0) {
    if (MAP == 1) { const int up = n0 >= DFF ? 1 : 0, j = n0 - up * DFF; return 256 * (j >> 7) + 128 * up + (j & 127); }
    if (MAP == 2) { const int pn = n0 >> 8, r = n0 & 255, wc = r >> 6, bj = (r >> 5) & 1; return 256 * pn + 128 * bj + 32 * wc; }
    return n0;
}
template <int MAP> __device__ __forceinline__ void conv_item(const float* W, int K, int N, bf16_t* WT, const float* gain, LAS float* scr, int item, int lane) {
    const int nblk = N / 64, kb = item / nblk, nb = item % nblk, k0 = 64 * kb, n0 = 64 * nb;
    const int c4 = lane & 15, kr = lane >> 4;
    f32x4 v[16];
#pragma unroll
    for (int i = 0; i < 16; ++i) v[i] = *(const f32x4*)(W + (size_t)(k0 + 4 * i + kr) * N + n0 + 4 * c4);
    if (gain) {
#pragma unroll
        for (int i = 0; i < 16; ++i) v[i] = v[i] * gain[k0 + 4 * i + kr];
    }
#pragma unroll
    for (int i = 0; i < 16; ++i) { const int kk = 4 * i + kr; LAS float* t = scr + (4 * c4) * 65 + kk; t[0] = v[i][0]; t[65] = v[i][1]; t[130] = v[i][2]; t[195] = v[i][3]; }
    asm volatile("s_waitcnt lgkmcnt(0)" ::: "memory");
    const int c = lane & 7, nr = lane >> 3;
#pragma unroll
    for (int j = 0; j < 8; ++j) { const int n = nr + 8 * j; const LAS float* t = scr + n * 65 + 8 * c;
        u32x4 o; o.x = pk2(t[0], t[1]); o.y = pk2(t[2], t[3]); o.z = pk2(t[4], t[5]); o.w = pk2(t[6], t[7]);
        const int r = map_row<MAP>(n0 + (n & 32)) + (n & 31);
        *(u32x4*)(WT + (size_t)r * K + k0 + 8 * c) = o; }
    asm volatile("s_waitcnt lgkmcnt(0)" ::: "memory");
}

__device__ __forceinline__ int lane_id() { int l; asm volatile("v_mbcnt_lo_u32_b32 %0, -1, 0\n\tv_mbcnt_hi_u32_b32 %0, -1, %0" : "=v"(l)); return l; }
__device__ __forceinline__ int opaque_int(int v) { asm volatile("" : "+s"(v)); return v; }
__device__ __forceinline__ unsigned char* opaque_ptr(unsigned char* p) { unsigned z = 0; asm volatile("" : "+s"(z)); return p + z; }
struct Args { const float* in[19]; float* out; unsigned char* ws; int ph_lo, ph_hi; };

template <int MAP> __device__ __forceinline__ void conv_mat(const float* W, int K, int N, bf16_t* WT, const float* gain, LAS float* scr, int gw, int NGW, int& off, int lane) {
    const int nitems = (K / 64) * (N / 64);
    int start = gw - off; if (start < 0) start += NGW;
    for (int it = start; it < nitems; it += NGW) conv_item<MAP>(W, K, N, WT, gain, scr, it, lane);
    off = (off + nitems) % NGW;
}

__device__ __forceinline__ void prologue(const Args& a, LAS unsigned char* lds, int G) {
    const int tid = threadIdx.x, lane = tid & 63, wave = tid >> 6;
    const int gw = blockIdx.x * 8 + wave, NGW = G * 8;
    unsigned char* ws = a.ws;
    { unsigned* ss = (unsigned*)(ws + WS_SS) + M; const int n4 = 16 * M / 4;
      for (int i = blockIdx.x * 512 + tid; i < n4; i += G * 512) ((f32x4*)ss)[i] = (f32x4){0.f, 0.f, 0.f, 0.f}; }
    { unsigned* ss0 = (unsigned*)(ws + WS_SS); bf16_t* xb = (bf16_t*)(ws + WS_XB);
      for (int m0 = gw; m0 < M; m0 += 4 * NGW) {
          f32x4 v[4][4];
#pragma unroll
          for (int r = 0; r < 4; ++r) { const int m = m0 + r * NGW; if (m < M) { const f32x4* xr = (const f32x4*)(a.in[0] + (size_t)m * D) + lane;
#pragma unroll
              for (int j = 0; j < 4; ++j) v[r][j] = xr[64 * j]; } }
#pragma unroll
          for (int r = 0; r < 4; ++r) { const int m = m0 + r * NGW; if (m < M) { u32x2* brow = (u32x2*)(xb + (size_t)m * D) + lane; float s = 0.f;
#pragma unroll
              for (int j = 0; j < 4; ++j) { const f32x4 q = v[r][j]; u32x2 w; w.x = pk2(q[0], q[1]); w.y = pk2(q[2], q[3]); brow[64 * j] = w; s += (q[0] * q[0] + q[1] * q[1]) + (q[2] * q[2] + q[3] * q[3]); }
              s = wave_sum(s, lane); if (lane == 0) ss0[m] = __float2uint_rn(s * pg8::SS_SCALE); } }
      } }
    const bool defer = G == 256;
    if (!defer) { const f32x4* p4 = (const f32x4*)a.in[1]; u32x4* pb = (u32x4*)(ws + WS_PB); const int n8 = DEPTH * M * PLE / 8;
      for (int i = blockIdx.x * 512 + tid; i < n8; i += G * 512) { const f32x4 v0 = p4[2 * i], v1 = p4[2 * i + 1]; u32x4 w; w.x = pk2(v0[0], v0[1]); w.y = pk2(v0[2], v0[3]); w.z = pk2(v1[0], v1[1]); w.w = pk2(v1[2], v1[3]); pb[i] = w; } }
    LAS float* scr = (LAS float*)(lds + wave * 16640);
    int off = 0;
#pragma unroll 1
    for (int l = 0; l < DEPTH; ++l) {
        conv_mat<1>(a.in[3] + (size_t)l * D * 2 * DFF, D, 2 * DFF, (bf16_t*)(ws + WS_WGU + (size_t)(2 * l) * SZ_WGU), a.in[2] + l * D, scr, gw, NGW, off, lane);
        conv_mat<1>(a.in[14] + (size_t)l * D * 2 * DFF, D, 2 * DFF, (bf16_t*)(ws + WS_WGU + (size_t)(2 * l + 1) * SZ_WGU), a.in[13] + l * D, scr, gw, NGW, off, lane);
        conv_mat<0>(a.in[4] + (size_t)l * DFF * D, DFF, D, (bf16_t*)(ws + WS_WDN + (size_t)(2 * l) * SZ_WDN), nullptr, scr, gw, NGW, off, lane);
        conv_mat<0>(a.in[15] + (size_t)l * DFF * D, DFF, D, (bf16_t*)(ws + WS_WDN + (size_t)(2 * l + 1) * SZ_WDN), nullptr, scr, gw, NGW, off, lane);
        conv_mat<0>(a.in[17] + (size_t)l * D * D, D, D, (bf16_t*)(ws + WS_WGATE + (size_t)l * SZ_WDD), a.in[16] + l * D, scr, gw, NGW, off, lane);
        conv_mat<0>(a.in[18] + (size_t)l * PLE * D, PLE, D, (bf16_t*)(ws + WS_WPROJ + (size_t)l * SZ_WPROJ), nullptr, scr, gw, NGW, off, lane);
    }
#pragma unroll 1
    for (int j = 0; j < 2; ++j) {
        conv_mat<2>(a.in[6] + (size_t)j * D * 3 * D, D, 3 * D, (bf16_t*)(ws + WS_WQKV + (size_t)j * SZ_WQKV), a.in[5] + (2 * j) * D, scr, gw, NGW, off, lane);
        conv_mat<0>(a.in[9] + (size_t)j * D * D, D, D, (bf16_t*)(ws + WS_WO + (size_t)j * SZ_WDD), nullptr, scr, gw, NGW, off, lane);
        conv_mat<0>(a.in[10] + (size_t)j * D * D, D, D, (bf16_t*)(ws + WS_WIN + (size_t)j * SZ_WDD), a.in[5] + (2 * j + 1) * D, scr, gw, NGW, off, lane);
#pragma unroll 1
        for (int g = 0; g < 4; ++g)
            conv_mat<0>(a.in[11] + (size_t)(j * 4 + g) * 256 * 256, 256, 256, (bf16_t*)(ws + WS_WGRP + (size_t)j * SZ_WGRP + (size_t)g * 256 * 256 * 2), nullptr, scr, gw, NGW, off, lane);
    }
}

__device__ __forceinline__ void unpack8(const u32x4 w, float* f) {
    f[0] = pg8::bf_lo(w.x); f[1] = pg8::bf_hi(w.x); f[2] = pg8::bf_lo(w.y); f[3] = pg8::bf_hi(w.y); f[4] = pg8::bf_lo(w.z); f[5] = pg8::bf_hi(w.z); f[6] = pg8::bf_lo(w.w); f[7] = pg8::bf_hi(w.w);
}
template <int W> __device__ __forceinline__ void pool_strip(const bf16_t* up, bf16_t* pp, int t0) {
    constexpr int NR = 15 + W;
    u32x4 raw[NR];
#pragma unroll
    for (int j = 0; j < NR; ++j) { const int dj = j - (W - 1); raw[j] = (t0 + dj >= 0) ? *(const u32x4*)(up + (ptrdiff_t)dj * D) : (u32x4){0u, 0u, 0u, 0u}; }
    float S[8];
#pragma unroll
    for (int e = 0; e < 8; ++e) S[e] = 0.f;
#pragma unroll
    for (int j = 0; j < W - 1; ++j) { float f[8]; unpack8(raw[j], f);
#pragma unroll
        for (int e = 0; e < 8; ++e) S[e] += f[e]; }
#pragma unroll
    for (int r = 0; r < 16; ++r) {
        float cur[8]; unpack8(raw[r + W - 1], cur);
        const int t = t0 + r; const float ic = 1.0f / (float)(t + 1 < W ? t + 1 : W); float o[8];
#pragma unroll
        for (int e = 0; e < 8; ++e) { S[e] += cur[e]; o[e] = S[e] * ic - cur[e]; }
        u32x4 ow; ow.x = pk2(o[0], o[1]); ow.y = pk2(o[2], o[3]); ow.z = pk2(o[4], o[5]); ow.w = pk2(o[6], o[7]);
        *(u32x4*)(pp + (ptrdiff_t)r * D) = ow;
        float old[8]; unpack8(raw[r], old);
#pragma unroll
        for (int e = 0; e < 8; ++e) S[e] -= old[e];
    }
}
__device__ __forceinline__ void pool_phase(const bf16_t* U, bf16_t* P, int G, int wv) {
    int lane_ = lane_id(); asm volatile("" : "+v"(lane_));
    const int lane = lane_;
    for (int it = blockIdx.x * 8 + wv; it < (M / 32) * 4; it += G * 8) {
        const int grp = it & 3, sp = it >> 2, strip = 2 * sp + (lane >> 5), chunk = grp * 32 + (lane & 31), row0 = strip * 16, t0 = row0 & (SEQ - 1);
        const bf16_t* up = U + (size_t)row0 * D + chunk * 8; bf16_t* pp = P + (size_t)row0 * D + chunk * 8;
        if (grp == 0) pool_strip<2>(up, pp, t0); else if (grp == 1) pool_strip<4>(up, pp, t0); else if (grp == 2) pool_strip<8>(up, pp, t0); else pool_strip<16>(up, pp, t0);
    }
}

__device__ __forceinline__ void pool_unit(const bf16_t* U, bf16_t* P, int pm, int pn, int wv) {
    int lane_ = lane_id(); asm volatile("" : "+v"(lane_));
    const int tid = wv * 64 + lane_, strip = pm * 16 + (tid >> 5), chunk = pn * 32 + (tid & 31), row0 = strip * 16, t0 = row0 & (SEQ - 1);
    const bf16_t* up = U + (size_t)row0 * D + chunk * 8; bf16_t* pp = P + (size_t)row0 * D + chunk * 8;
    if (pn == 0) pool_strip<2>(up, pp, t0); else if (pn == 1) pool_strip<4>(up, pp, t0); else if (pn == 2) pool_strip<8>(up, pp, t0); else pool_strip<16>(up, pp, t0);
}

__device__ __forceinline__ void attn_phase(LAS unsigned char* lds, const bf16_t* Q, const bf16_t* Kg, const bf16_t* Vg, bf16_t* O, int G, int wv) {
    LAS bf16_t* Ks0 = (LAS bf16_t*)lds;
    LAS bf16_t* Vt0 = (LAS bf16_t*)(lds + 2 * 9216);
    LAS unsigned* flags0 = (LAS unsigned*)(lds + 2 * 9216 + 2 * 8704);
    int par = 0;
    int tid_ = wv * 64 + lane_id(); asm volatile("" : "+v"(tid_));
    const int tid = tid_, wid = tid >> 6, lane = tid & 63, l16 = lane & 15, g = lane >> 4;
    constexpr int NU = 2 * NH * (SEQ / 128);
    const int key = tid >> 3, dc = tid & 7;
    bf16x8 qf[2]; u32x4 kv, vv;
    if ((int)blockIdx.x < NU) { const int unit = blockIdx.x, qblk = unit & 63, bh = unit >> 6, b = bh >> 4, h = bh & 15; const size_t rowbase = (size_t)b * SEQ;
        const bf16_t* qp = Q + (rowbase + qblk * 128 + wid * 16 + l16) * D + h * HD + 8 * g; qf[0] = *(const bf16x8*)qp; qf[1] = *(const bf16x8*)(qp + 32);
        const size_t src = (rowbase + key) * D + h * HD + 8 * dc + (size_t)(2 * qblk + 1) * 64 * D; kv = *(const u32x4*)(Kg + src); vv = *(const u32x4*)(Vg + src); }
    for (int unit = blockIdx.x; unit < NU; unit += G) {
        const int qblk = unit & 63, bh = unit >> 6, b = bh >> 4, h = bh & 15;
        const size_t rowbase = (size_t)b * SEQ; const int t0 = qblk * 128 + wid * 16, tq = t0 + l16;
        const bool has_next = unit + G < NU;
        bf16x8 qn[2]; u32x4 kvn, vvn;
        if (has_next) { const int un = unit + G, qb2 = un & 63, bh2 = un >> 6, b2 = bh2 >> 4, h2 = bh2 & 15; const size_t rb2 = (size_t)b2 * SEQ;
            const bf16_t* qp = Q + (rb2 + qb2 * 128 + wid * 16 + l16) * D + h2 * HD + 8 * g; qn[0] = *(const bf16x8*)qp; qn[1] = *(const bf16x8*)(qp + 32);
            const size_t src = (rb2 + key) * D + h2 * HD + 8 * dc + (size_t)(2 * qb2 + 1) * 64 * D; kvn = *(const u32x4*)(Kg + src); vvn = *(const u32x4*)(Vg + src); }
        f32x4 o[4];
#pragma unroll
        for (int i = 0; i < 4; ++i) o[i] = (f32x4){0.f, 0.f, 0.f, 0.f};
        float carry = 1.f; unsigned wave_done = 0u;
        const size_t srcb = (rowbase + key) * D + h * HD + 8 * dc;
        for (int kt = 2 * qblk + 1; kt >= 0; --kt) {
            LAS bf16_t* Ks = Ks0 + par * (64 * 72); LAS bf16_t* Vt = Vt0 + par * (64 * 68); LAS unsigned* flags = flags0 + par * 8; par ^= 1;
            if (lane == 0) flags[wid] = wave_done;
            { *(LAS u32x4*)(Ks + key * 72 + 8 * dc) = kv;
              LAS bf16_t* vd = Vt + (8 * dc) * 68 + key;
              vd[0 * 68] = (bf16_t)(vv.x & 0xffffu); vd[1 * 68] = (bf16_t)(vv.x >> 16); vd[2 * 68] = (bf16_t)(vv.y & 0xffffu); vd[3 * 68] = (bf16_t)(vv.y >> 16);
              vd[4 * 68] = (bf16_t)(vv.z & 0xffffu); vd[5 * 68] = (bf16_t)(vv.z >> 16); vd[6 * 68] = (bf16_t)(vv.w & 0xffffu); vd[7 * 68] = (bf16_t)(vv.w >> 16); }
            __syncthreads();
            unsigned all = 1u;
#pragma unroll
            for (int i = 0; i < 8; ++i) all &= flags[i];
            if (all) break;
            if (kt > 0) { const size_t src = srcb + (size_t)(kt - 1) * 64 * D; kv = *(const u32x4*)(Kg + src); vv = *(const u32x4*)(Vg + src); }
            if (!wave_done && kt * 64 <= t0 + 14) {
                f32x4 z[4];
#pragma unroll
                for (int bb = 0; bb < 4; ++bb) { z[bb] = (f32x4){0.f, 0.f, 0.f, 0.f};
#pragma unroll
                    for (int ks = 0; ks < 2; ++ks) { const bf16x8 ka = *(const LAS bf16x8*)(Ks + (16 * bb + l16) * 72 + 32 * ks + 8 * g); z[bb] = __builtin_amdgcn_mfma_f32_16x16x32_bf16(ka, qf[ks], z[bb], 0, 0, 0); } }
                f32x2 st[4][2], be[4][2]; float tot[4], Ex[4];
                const bool diag = kt * 64 + 63 >= t0;
#pragma unroll
                for (int bb = 0; bb < 4; ++bb) {
#pragma unroll
                    for (int h = 0; h < 2; ++h) {
                        const f32x2 t = (f32x2){z[bb][2 * h], z[bb][2 * h + 1]} * 1.44269504089f;
                        f32x2 e; e.x = __builtin_amdgcn_exp2f(t.x); e.y = __builtin_amdgcn_exp2f(t.y);
                        const f32x2 d = e + 1.0f;
                        f32x2 r; r.x = __builtin_amdgcn_rcpf(d.x); r.y = __builtin_amdgcn_rcpf(d.y);
                        f32x2 b_ = 1.0f - r;
                        if (diag) { const int s = kt * 64 + 16 * bb + 4 * g + 2 * h;
                            if (!(s < tq)) { r.x = 1.f; b_.x = 0.f; }
                            if (!(s + 1 < tq)) { r.y = 1.f; b_.y = 0.f; } }
                        st[bb][h] = r; be[bb][h] = b_;
                    }
                    const f32x2 pp = st[bb][0] * st[bb][1]; const float T = pp.x * pp.y;
                    const float a_ = shx(T, lane, 16), b2 = T * a_, c_ = shx(b2, lane, 32);
                    tot[bb] = b2 * c_; Ex[bb] = ((g & 1) == 0 ? a_ : 1.f) * ((g & 2) == 0 ? c_ : 1.f);
                }
                float wv[4][4]; float right = carry;
#pragma unroll
                for (int bb = 3; bb >= 0; --bb) {
                    const float base = right * Ex[bb];
                    const float p2 = st[bb][1].y, p1 = p2 * st[bb][1].x, p0 = p1 * st[bb][0].y;
                    const f32x2 w1 = (be[bb][1] * (f32x2){p2, 1.f}) * base, w0 = (be[bb][0] * (f32x2){p0, p1}) * base;
                    wv[bb][0] = w0.x; wv[bb][1] = w0.y; wv[bb][2] = w1.x; wv[bb][3] = w1.y;
                    right *= tot[bb];
                }
                carry = right;
#pragma unroll
                for (int c = 0; c < 2; ++c) {
                    u32x4 pw; pw.x = pg8::cvt_pk_bf16(wv[2 * c][0], wv[2 * c][1]); pw.y = pg8::cvt_pk_bf16(wv[2 * c][2], wv[2 * c][3]);
                    pw.z = pg8::cvt_pk_bf16(wv[2 * c + 1][0], wv[2 * c + 1][1]); pw.w = pg8::cvt_pk_bf16(wv[2 * c + 1][2], wv[2 * c + 1][3]);
                    const bf16x8 pbf = __builtin_bit_cast(bf16x8, pw);
#pragma unroll
                    for (int db = 0; db < 4; ++db) {
                        const LAS bf16_t* vp = Vt + (16 * db + l16) * 68 + 32 * c + 4 * g;
                        const u32x2 v0 = *(const LAS u32x2*)vp, v1 = *(const LAS u32x2*)(vp + 16);
                        u32x4 va; va.x = v0.x; va.y = v0.y; va.z = v1.x; va.w = v1.y;
                        o[db] = __builtin_amdgcn_mfma_f32_16x16x32_bf16(__builtin_bit_cast(bf16x8, va), pbf, o[db], 0, 0, 0);
                    }
                }
                wave_done = (__builtin_amdgcn_ballot_w64(carry < 1e-37f) == ~0ull) ? 1u : 0u;
            }
        }
        { bf16_t* op = O + (rowbase + tq) * D + h * HD + 4 * g;
#pragma unroll
          for (int db = 0; db < 4; ++db) { u32x2 w; w.x = pg8::cvt_pk_bf16(o[db][0], o[db][1]); w.y = pg8::cvt_pk_bf16(o[db][2], o[db][3]); *(u32x2*)(op + 16 * db) = w; } }
        if (has_next) { qf[0] = qn[0]; qf[1] = qn[1]; kv = kvn; vv = vvn; }
    }
    __syncthreads();
}

#define XB_TMO      128
#define XB_XCNT(j)  (256  + 64 * (j))
#define XB_XSUB(j)  (1280 + 64 * (j))
#define XB_XGEN(j)  (2304 + 64 * (j))
#define XB_TOP      3328
#define XB_TOPGEN   3392
#define XCD_BAR_WORDS 3456
#define XB_SPIN_CAP (1u << 18)
__device__ __forceinline__ unsigned xb_ld(unsigned* p)              { return __hip_atomic_load(p, __ATOMIC_RELAXED, __HIP_MEMORY_SCOPE_AGENT); }
__device__ __forceinline__ unsigned xb_add(unsigned* p, unsigned v) { return __hip_atomic_fetch_add(p, v, __ATOMIC_RELAXED, __HIP_MEMORY_SCOPE_AGENT); }
__device__ __forceinline__ unsigned xb_xcc_id() { return (unsigned)__builtin_amdgcn_s_getreg((3 << 11) | 20) & 0xFu; }
#define XB_SPIN(cond, bar) do { unsigned _sp = 0; while (cond) { __builtin_amdgcn_s_sleep(1); \
    if ((++_sp & 255u) == 0u) { if (xb_ld(&(bar)[XB_TMO])) break; if (_sp > XB_SPIN_CAP) { atomicAdd(&(bar)[XB_TMO], 1u); break; } } } } while (0)
struct XcdBarrier { unsigned* bar; unsigned x; volatile LAS unsigned* st; };
__device__ __forceinline__ XcdBarrier xcd_barrier_post(unsigned* bar, volatile LAS unsigned* st) {
    XcdBarrier b; b.bar = bar; b.x = xb_xcc_id(); b.st = st;
    if (threadIdx.x == 0) (void)xb_add(&bar[XB_XCNT(b.x)], 1u);
    return b;
}
__device__ __forceinline__ void xcd_barrier_complete(unsigned* bar, unsigned x, unsigned& nloc, unsigned& nx, unsigned& mask) {
    const unsigned G = gridDim.x * gridDim.y * gridDim.z;
    unsigned sum, cnt, mine, sp = 0u;
    for (;;) {
        sum = 0u; cnt = 0u; mine = 0u; mask = 0u;
#pragma unroll
        for (unsigned j = 0; j < 16; ++j) { const unsigned c = xb_ld(&bar[XB_XCNT(j)]); sum += c; cnt += (c > 0u) ? 1u : 0u; mask |= (c > 0u) ? (1u << j) : 0u; mine = (j == x) ? c : mine; }
        if (sum == G) break;
        __builtin_amdgcn_s_sleep(1);
        if ((++sp & 255u) == 0u) { if (xb_ld(&bar[XB_TMO])) break; if (sp > XB_SPIN_CAP) { atomicAdd(&bar[XB_TMO], 1u); break; } }
    }
    nloc = mine > 0u ? mine : 1u; nx = cnt > 0u ? cnt : 1u;
}
__device__ __forceinline__ void xcd_barrier(const XcdBarrier& b, int wv) {
    asm volatile("s_waitcnt vmcnt(0)" ::: "memory");
    __syncthreads();
    if (opaque_int(wv) == 0) { if (lane_id() == 0) {
        unsigned* bar = (unsigned*)opaque_ptr((unsigned char*)b.bar);
        __builtin_amdgcn_s_waitcnt(0);
        unsigned nloc = b.st[0], nx = b.st[1], mask = b.st[2];
        if (nloc == 0u) { xcd_barrier_complete(bar, b.x, nloc, nx, mask); b.st[0] = nloc; b.st[1] = nx; b.st[2] = mask; }
        const unsigned old = xb_add(&bar[XB_XSUB(b.x)], 1u);
        const unsigned gen = old / nloc;
        if (old + 1u == (gen + 1u) * nloc) {
            __builtin_amdgcn_fence(__ATOMIC_RELEASE, "agent");
            asm volatile("s_waitcnt vmcnt(0)" ::: "memory");
            const unsigned og = xb_add(&bar[XB_TOP], 1u);
            const unsigned tg = og / nx;
            if (og + 1u == (tg + 1u) * nx) {
#pragma unroll 1
                for (unsigned j = 0; j < 16; ++j) if ((mask >> j) & 1u) (void)__hip_atomic_fetch_add(&bar[XB_XGEN(j)], 1u, __ATOMIC_RELAXED, __HIP_MEMORY_SCOPE_AGENT);
            } else XB_SPIN(xb_ld(&bar[XB_XGEN(b.x)]) == gen, bar);
            __builtin_amdgcn_fence(__ATOMIC_ACQUIRE, "agent");
            asm volatile("s_waitcnt vmcnt(0)" ::: "memory");
        } else {
            XB_SPIN(xb_ld(&bar[XB_XGEN(b.x)]) == gen, bar);
            __builtin_amdgcn_fence(__ATOMIC_ACQUIRE, "agent");
            asm volatile("s_waitcnt vmcnt(0)" ::: "memory");
        }
    } }
    __syncthreads();
}

__global__ void __launch_bounds__(512, 2) fwd_kernel(Args a) {
    extern __shared__ __attribute__((aligned(16))) unsigned char lds_raw[];
    LAS unsigned char* lds = (LAS unsigned char*)lds_raw;
    const int G0 = gridDim.x, bid0 = blockIdx.x, wv = __builtin_amdgcn_readfirstlane(threadIdx.x >> 6);
    unsigned char* ws0 = a.ws; float* X = a.out;
    volatile LAS unsigned* bst = (volatile LAS unsigned*)(lds + LDS_BYTES - 64);
    if (threadIdx.x < 4) bst[threadIdx.x] = 0u;
    __syncthreads();
    XcdBarrier xbar; xbar.bar = (unsigned*)(ws0 + WS_BAR); xbar.x = 0; xbar.st = bst;
#define REP(bit) _Pragma("unroll 1") for (int rep_ = 0, nrep_ = opaque_int((DUP_MASK & (bit)) ? 2 : 1); rep_ < nrep_; ++rep_)
#define OPQ() unsigned char* ws = opaque_ptr(ws0); const int G = opaque_int(G0), bid = opaque_int(bid0); pg8::ss_t* SS = (pg8::ss_t*)(ws + WS_SS); bf16_t* XB = (bf16_t*)(ws + ((l & 1) ? WS_XB2 : WS_XB)); bf16_t* XBN = (bf16_t*)(ws + ((l & 1) ? WS_XB : WS_XB2)); bf16_t* R1 = (bf16_t*)(ws + WS_R1); \
        bf16_t* ACT = R1; bf16_t* Qb = R1; bf16_t* Kb = R1 + (size_t)M * D; bf16_t* Vb = R1 + (size_t)2 * M * D; bf16_t* Ob = R1 + (size_t)3 * M * D; bf16_t* Ub = R1; bf16_t* PLb = R1 + (size_t)M * D; bf16_t* PE = (bf16_t*)(ws + WS_PE); \
        (void)SS; (void)XB; (void)XBN; (void)ACT; (void)Qb; (void)Kb; (void)Vb; (void)Ob; (void)Ub; (void)PLb; (void)PE; (void)G; (void)bid
#define SEAM() xcd_barrier(xbar, wv)
#define GEMM_SEAM(first) do { pg8::gemm_prefetch_b(lds, g, S, wv); if (first) { asm volatile("s_waitcnt vmcnt(0)" ::: "memory"); __syncthreads(); } else SEAM(); } while (0)
    xbar = xcd_barrier_post((unsigned*)(ws0 + WS_BAR), bst);
    prologue(a, lds, G0);
    __syncthreads();
    if (a.ph_lo != 0) cg::this_grid().sync();
#pragma unroll 1
    for (int l = 0; l < DEPTH; ++l) {
        const int j = l >> 1; const bool is_attn = (l & 1) == 0;
        pg8::StaticOrder S;
#pragma unroll 1
        for (int f = 0; f < 2; ++f) {
            {
                OPQ();
                pg8::Gemm g{XB, (const bf16_t*)(ws + WS_WGU + (size_t)(2 * l + f) * SZ_WGU), D, D, D, 0, 0, 1}; S.init(M, 2 * DFF, G, bid);
                pg8::EpiGU E{SS + (size_t)(4 * l + 2 * f) * M, ACT};
                GEMM_SEAM(false);
                pg8::gemm_phase<pg8::EpiGU, true, true>(lds, g, S, E, wv);
                if (DUP_MASK & 8) { pg8::gemm_phase<pg8::EpiGU, true, false>(lds, g, S, E, wv); }
                if (DUP_MASK & 2048) { pg8::EpiNull EN; pg8::gemm_phase<pg8::EpiNull, true, false>(lds, g, S, EN, wv); }
                if (DUP_MASK & 4096) { pg8::EpiNull EN; pg8::Gemm gp = g; gp.umask = opaque_int(0); pg8::gemm_phase<pg8::EpiNull, true, false>(lds, gp, S, EN, wv); }
                if (f == 0 && G == 256 && bid >= 128) {
                    const int tid2 = wv * 64 + lane_id(), sb = bid - 128;
                    const f32x4* p4 = (const f32x4*)(a.in[1] + (size_t)l * M * PLE); u32x4* pb = (u32x4*)(ws + WS_PB + (size_t)l * M * PLE * 2); const int n8 = M * PLE / 8;
                    for (int i = sb * 512 + tid2; i < n8; i += 128 * 512) { const f32x4 v0 = p4[2 * i], v1 = p4[2 * i + 1]; u32x4 w; w.x = pk2(v0[0], v0[1]); w.y = pk2(v0[2], v0[3]); w.z = pk2(v1[0], v1[1]); w.w = pk2(v1[2], v1[3]); pb[i] = w; }
                }
                if (f == 1 && G == 256 && bid >= 128) {
                    pg8::Gemm g2{(const bf16_t*)(ws + WS_PB) + (size_t)l * M * PLE, (const bf16_t*)(ws + WS_WPROJ + (size_t)l * SZ_WPROJ), PLE, PLE, PLE, 0, 0, 1}; pg8::StaticOrder S2; S2.init(M, D, 128, bid - 128);
                    pg8::EpiBf16S<false> E2{nullptr, PE, D};
                    pg8::gemm_phase<pg8::EpiBf16S<false>, false, false>(lds, g2, S2, E2, wv);
                }
            }
            {
                OPQ();
                pg8::Gemm g{ACT, (const bf16_t*)(ws + WS_WDN + (size_t)(2 * l + f) * SZ_WDN), DFF, DFF, DFF, 0, 0, 1}; S.init(M, D, G, bid);
                pg8::EpiRes<0> E{XB, XB, nullptr, SS + (size_t)(4 * l + 2 * f + 1) * M, 0.5f, nullptr, nullptr, nullptr};
                GEMM_SEAM(false);
                pg8::gemm_phase<pg8::EpiRes<0>, false, true>(lds, g, S, E, wv);
            }
            if (f == 0) {
                if (is_attn) {
                    { OPQ();
                      pg8::Gemm g{XB, (const bf16_t*)(ws + WS_WQKV + (size_t)j * SZ_WQKV), D, D, D, 0, 0, 1}; S.init(M, 3 * D, G, bid);
                      pg8::EpiQKV E{SS + (size_t)(4 * l + 1) * M, Qb, a.in[7] + j * HD, a.in[8] + j * HD};
                      GEMM_SEAM(false);
                      pg8::gemm_phase<pg8::EpiQKV, true, true>(lds, g, S, E, wv); }
                    SEAM();
                    { OPQ(); REP(4) attn_phase(lds, Qb, Kb, Vb, Ob, G, wv); }
                    { OPQ();
                      pg8::Gemm g{Ob, (const bf16_t*)(ws + WS_WO + (size_t)j * SZ_WDD), D, D, D, 0, 0, 1}; S.init(M, D, G, bid);
                      pg8::EpiRes<0> E{XB, XB, nullptr, SS + (size_t)(4 * l + 2) * M, 1.0f, nullptr, nullptr, nullptr};
                      GEMM_SEAM(false);
                      pg8::gemm_phase<pg8::EpiRes<0>, false, true>(lds, g, S, E, wv); }
                } else {
                    { OPQ();
                      pg8::Gemm g{XB, (const bf16_t*)(ws + WS_WIN + (size_t)j * SZ_WDD), D, D, D, 0, 0, 1}; S.init(M, D, G, bid);
                      pg8::EpiBf16S<true> E{SS + (size_t)(4 * l + 1) * M, Ub, D};
                      GEMM_SEAM(false);
                      pg8::gemm_phase<pg8::EpiBf16S<true>, false, true>(lds, g, S, E, wv); }
                    { OPQ();
                      pg8::Gemm g{PLb, (const bf16_t*)(ws + WS_WGRP + (size_t)j * SZ_WGRP), D, 256, 256, 256, 0, 1}; S.init(M, D, G, bid);
                      pg8::EpiRes<1> E{XB, XB, nullptr, SS + (size_t)(4 * l + 2) * M, 1.0f, a.in[12] + j * D, nullptr, nullptr};
                      GEMM_SEAM(false);
                      { pg8::Unit pu; for (int i = 0; S.next(i, pu); ++i) pool_unit(Ub, PLb, pu.pm, pu.pn, wv); }
                      asm volatile("s_waitcnt vmcnt(0)" ::: "memory"); __syncthreads();
                      pg8::gemm_phase<pg8::EpiRes<1>, false, true>(lds, g, S, E, wv); }
                }
            }
        }
        {
            OPQ();
            if (G != 256) { SEAM();
              pg8::Gemm g{(const bf16_t*)(ws + WS_PB) + (size_t)l * M * PLE, (const bf16_t*)(ws + WS_WPROJ + (size_t)l * SZ_WPROJ), PLE, PLE, PLE, 0, 0, 1}; S.init(M, D, G, bid);
              pg8::EpiBf16S<false> E{nullptr, PE, D};
              pg8::gemm_phase<pg8::EpiBf16S<false>, false, false>(lds, g, S, E, wv); }
            pg8::Gemm g{XB, (const bf16_t*)(ws + WS_WGATE + (size_t)l * SZ_WDD), D, D, D, 0, 0, 1}; S.init(M, D, G, bid);
            pg8::EpiRes<2> E{XB, XBN, l == DEPTH - 1 ? X : nullptr, SS + (size_t)(4 * l + 4) * M, 1.0f, nullptr, SS + (size_t)(4 * l + 3) * M, PE};
            GEMM_SEAM(false);
            pg8::gemm_phase<pg8::EpiRes<2>, false, true>(lds, g, S, E, wv);
        }
    }
#undef OPQ
#undef SEAM
#undef GEMM_SEAM
}

extern "C" void kernel_launch(void* const* d_in, const int* in_sizes, int n_in, void* d_out, int out_size, void* d_ws, size_t ws_size, hipStream_t stream) {
    static int grid = 0;
    if (grid == 0) {
        if (n_in != 19 || out_size != M * D || ws_size < WS_END) { fprintf(stderr, "kernel_launch: unexpected shapes (n_in %d, out %d, ws %zu, need %zu)\n", n_in, out_size, ws_size, (size_t)WS_END); grid = -1; return; }
        int dev = 0, cus = 0, per_cu = 0;
        hipGetDevice(&dev); hipDeviceGetAttribute(&cus, hipDeviceAttributeMultiprocessorCount, dev);
        if (hipFuncSetAttribute((const void*)fwd_kernel, hipFuncAttributeMaxDynamicSharedMemorySize, LDS_BYTES) != hipSuccess) { fprintf(stderr, "kernel_launch: hipFuncSetAttribute failed\n"); }
        if (hipOccupancyMaxActiveBlocksPerMultiprocessor(&per_cu, (const void*)fwd_kernel, 512, LDS_BYTES) != hipSuccess || per_cu < 1) per_cu = 1;
        (void)hipGetLastError();
        grid = cus * per_cu;
        fprintf(stderr, "kernel_launch: grid %d (cus %d x %d)\n", grid, cus, per_cu);
    }
    if (grid < 0) return;
    Args a{};
    for (int i = 0; i < 19; ++i) a.in[i] = (const float*)d_in[i];
    a.out = (float*)d_out; a.ws = (unsigned char*)d_ws;
    a.ph_lo = 0; a.ph_hi = NPHASE;
    if (hipMemsetAsync((char*)d_ws + WS_BAR, 0, 16384, stream) != hipSuccess) { fprintf(stderr, "kernel_launch: hipMemsetAsync of the barrier words failed\n"); return; }
    void* args[] = {&a};
    hipError_t e = hipLaunchCooperativeKernel((const void*)fwd_kernel, dim3(grid), dim3(512), args, LDS_BYTES, stream);
    if (e != hipSuccess) fprintf(stderr, "cooperative launch failed: %s (grid %d)\n", hipGetErrorString(e), grid);
}
```

```cpp
#include <hip/hip_runtime.h>
#include <hip/hip_cooperative_groups.h>
#include <cstdio>
#include <cstdint>
namespace cg = cooperative_groups;

#define LAS __attribute__((address_space(3)))
typedef unsigned short bf16_t;
typedef short bf16x8 __attribute__((ext_vector_type(8)));
typedef short s16x4 __attribute__((ext_vector_type(4)));
typedef float f32x4 __attribute__((ext_vector_type(4)));
typedef float f32x2 __attribute__((ext_vector_type(2)));
typedef unsigned u32x4 __attribute__((ext_vector_type(4)));
typedef unsigned u32x2 __attribute__((ext_vector_type(2)));

__device__ __forceinline__ int lane_id();
__device__ __forceinline__ int opaque_int(int v);
__device__ __forceinline__ unsigned char* opaque_ptr(unsigned char* p);
__device__ __forceinline__ float shx(float v, int lane, int m) { return __builtin_bit_cast(float, __builtin_amdgcn_ds_bpermute((lane ^ m) << 2, __builtin_bit_cast(int, v))); }
#ifndef DUP_MASK
#define DUP_MASK 0
#endif

constexpr int D = 1024, M = 16384, SEQ = 8192, DEPTH = 4, NH = 16, HD = 64, DFF = 2816, PLE = 256;
constexpr float EPS = 1e-6f;
constexpr int NPHASE = 1 + 8 * DEPTH;

constexpr size_t SZ_SS = (size_t)17 * M * 4;
constexpr size_t SZ_WGU = (size_t)2 * DFF * D * 2, SZ_WDN = (size_t)D * DFF * 2, SZ_WQKV = (size_t)3 * D * D * 2, SZ_WDD = (size_t)D * D * 2, SZ_WGRP = (size_t)4 * 256 * 256 * 2, SZ_WPROJ = (size_t)D * PLE * 2;
constexpr size_t WS_SS = 0;
constexpr size_t WS_BAR = 0x300000;
constexpr size_t WS_WGU = 4u << 20;
constexpr size_t WS_WDN = WS_WGU + 8 * SZ_WGU;
constexpr size_t WS_WQKV = WS_WDN + 8 * SZ_WDN;
constexpr size_t WS_WO = WS_WQKV + 2 * SZ_WQKV;
constexpr size_t WS_WIN = WS_WO + 2 * SZ_WDD;
constexpr size_t WS_WGRP = WS_WIN + 2 * SZ_WDD;
constexpr size_t WS_WGATE = WS_WGRP + 2 * SZ_WGRP;
constexpr size_t WS_WPROJ = WS_WGATE + 4 * SZ_WDD;
constexpr size_t WS_XB = WS_WPROJ + 4 * SZ_WPROJ;
constexpr size_t SZ_MD = (size_t)M * D * 2;
constexpr size_t WS_R1 = WS_XB + SZ_MD;
constexpr size_t WS_PB = WS_R1 + 4 * SZ_MD;
constexpr size_t WS_PE = WS_PB + SZ_MD;
constexpr size_t WS_XB2 = WS_PE + SZ_MD;
constexpr size_t WS_END = WS_XB2 + SZ_MD;
static_assert(SZ_SS <= WS_BAR && WS_BAR + 16384 <= WS_WGU && (size_t)M * DFF * 2 <= 4 * SZ_MD, "ws map");

constexpr int LDS_BYTES = 8 * 16640 + 256;

namespace pg8 {
constexpr int BM = 256, BK = 64, HALF = 128, HTB = HALF * BK * 2, STAGE_BYTES = 8 * HTB, NXCD = 8, WGM = 8;
__host__ __device__ __forceinline__ int lds_byte(int r, int c) { const int st = (r >> 4) * 2 + (c >> 5), rr = r & 15, cc = c & 31, ob = rr * 64 + cc * 2; return st * 1024 + (ob ^ (((ob >> 9) & 1) << 5)); }
__host__ __device__ __forceinline__ void stage_rc(int b, int& R, int& C) { const int st = b / 1024, sb = b % 1024, swz = sb ^ (((sb >> 9) & 1) << 5); R = (st >> 1) * 16 + swz / 64; C = (st & 1) * 32 + (swz % 64) / 2; }
__host__ __device__ __forceinline__ int perm32(int rho) { const int n = rho >> 4, i = rho & 15; return 8 * (i >> 2) + 4 * n + (i & 3); }

struct Unit { int pm, pn; };
struct Gemm { const bf16_t* A; const bf16_t* Bt; int lda, ldb, K; int a_pn_off; int stagger; int epi_rep; int umask = -1; };

struct StaticOrder {
    int nM, nN, nwg, G, c;
    __device__ void init(int M_, int N_, int G_, int c_) { nM = M_ / BM; nN = N_ / BM; nwg = nM * nN; G = G_; c = c_; }
    __device__ bool next(int i, Unit& u) const {
        const int L = i * G + c; if (L >= nwg) return false;
        int wgid = L; { const int q = nwg / NXCD, r = nwg % NXCD, xcd = wgid % NXCD, off = wgid / NXCD; wgid = (xcd < r ? xcd * (q + 1) : r * (q + 1) + (xcd - r) * q) + off; }
        const int nig = WGM * nN, gid = wgid / nig, fm = gid * WGM, gsz = (nM - fm) < WGM ? (nM - fm) : WGM;
        u.pm = fm + ((wgid % nig) % gsz); u.pn = (wgid % nig) / gsz; return true;
    }
};

__device__ __forceinline__ unsigned cvt_pk_bf16(float lo, float hi) { unsigned r; asm volatile("v_cvt_pk_bf16_f32 %0, %1, %2" : "=v"(r) : "v"(lo), "v"(hi)); return r; }
__device__ __forceinline__ u32x4 pack8(const f32x4 a, const f32x4 b) { u32x4 w; w.x = cvt_pk_bf16(a[0], a[1]); w.y = cvt_pk_bf16(a[2], a[3]); w.z = cvt_pk_bf16(b[0], b[1]); w.w = cvt_pk_bf16(b[2], b[3]); return w; }
__device__ __forceinline__ float bf_lo(unsigned w) { return __uint_as_float(w << 16); }
__device__ __forceinline__ float bf_hi(unsigned w) { return __uint_as_float(w & 0xffff0000u); }
__device__ __forceinline__ float fast_sigmoid(float v) { return __builtin_amdgcn_rcpf(1.0f + __expf(-v)); }

typedef f32x4 Acc[2][2][4][2];
typedef unsigned ss_t;
constexpr float SS_SCALE = 2048.0f;
__device__ __forceinline__ float ss_rinv_v(ss_t v) { return rsqrtf((float)v * (1.0f / (SS_SCALE * D)) + EPS); }
__device__ __forceinline__ void ss_pre(ss_t (&pv)[8], const ss_t* ss, const Unit& u, int wr, int fr) {
#pragma unroll
    for (int ai = 0; ai < 2; ++ai)
#pragma unroll
        for (int m = 0; m < 4; ++m) pv[ai * 4 + m] = ss[u.pm * BM + wr * 64 + fr + ai * HALF + m * 16];
}
__device__ __forceinline__ void ss_add(ss_t* ss, int row, float s2) { (void)__hip_atomic_fetch_add(ss + row, (unsigned)__float2uint_rn(s2 * SS_SCALE), __ATOMIC_RELAXED, __HIP_MEMORY_SCOPE_AGENT); }

struct EpiGU {
    const ss_t* ss; bf16_t* act;
    __device__ __forceinline__ void pre(ss_t (&pv)[8], const Unit& u, int wr, int fr) const { ss_pre(pv, ss, u, wr, fr); }
    __device__ __forceinline__ void operator()(const Acc& acc, const Unit& u, int wr, int wc, int fr, int fq, const ss_t (&pv)[8]) const {
        const int row0 = u.pm * BM + wr * 64 + fr, col = u.pn * 128 + wc * 32 + 8 * fq;
#pragma unroll
        for (int ai = 0; ai < 2; ++ai)
#pragma unroll
            for (int m = 0; m < 4; ++m) {
                const int row = row0 + ai * HALF + m * 16;
                const float rinv = ss_rinv_v(pv[ai * 4 + m]);
                f32x4 o[2];
#pragma unroll
                for (int n = 0; n < 2; ++n) {
#pragma unroll
                    for (int h = 0; h < 2; ++h) {
                        const f32x2 g = (f32x2){acc[ai][0][m][n][2 * h], acc[ai][0][m][n][2 * h + 1]} * rinv, up = (f32x2){acc[ai][1][m][n][2 * h], acc[ai][1][m][n][2 * h + 1]} * rinv;
                        const f32x2 t = g * (-1.44269504089f);
                        f32x2 e; e.x = __builtin_amdgcn_exp2f(t.x); e.y = __builtin_amdgcn_exp2f(t.y);
                        const f32x2 d = e + 1.0f;
                        f32x2 r; r.x = __builtin_amdgcn_rcpf(d.x); r.y = __builtin_amdgcn_rcpf(d.y);
                        const f32x2 v = (g * r) * up;
                        o[n][2 * h] = v.x; o[n][2 * h + 1] = v.y;
                    }
                }
                *(u32x4*)(act + (size_t)row * DFF + col) = pack8(o[0], o[1]);
            }
    }
};
template <int MODE> struct EpiRes {
    const bf16_t* XR; bf16_t* XW; float* OUT; ss_t* ss_next; float alpha; const float* colscale; const ss_t* ss_cur; const bf16_t* pe;
    __device__ __forceinline__ void pre(ss_t (&pv)[8], const Unit& u, int wr, int fr) const { if (MODE >= 2) ss_pre(pv, ss_cur, u, wr, fr); }
    __device__ __forceinline__ void operator()(const Acc& acc, const Unit& u, int wr, int wc, int fr, int fq, const ss_t (&pv)[8]) const {
        const int row0 = u.pm * BM + wr * 64 + fr, colb = u.pn * BM + wc * 32 + 8 * fq;
        f32x4 cs[2][2];
        if (MODE == 1) {
#pragma unroll
            for (int bj = 0; bj < 2; ++bj) { cs[bj][0] = *(const f32x4*)(colscale + colb + bj * HALF); cs[bj][1] = *(const f32x4*)(colscale + colb + bj * HALF + 4); }
        }
#pragma unroll
        for (int ai = 0; ai < 2; ++ai) {
            u32x4 xw[4][2], pw[4][2]; float rinv[4];
#pragma unroll
            for (int m = 0; m < 4; ++m) {
                const int row = row0 + ai * HALF + m * 16;
#pragma unroll
                for (int bj = 0; bj < 2; ++bj) { const size_t off = (size_t)row * D + colb + bj * HALF; xw[m][bj] = *(const u32x4*)(XR + off); if (MODE >= 2) pw[m][bj] = *(const u32x4*)(pe + off); }
                rinv[m] = 1.f; if (MODE >= 2) rinv[m] = ss_rinv_v(pv[ai * 4 + m]);
            }
#pragma unroll
            for (int m = 0; m < 4; ++m) {
                const int row = row0 + ai * HALF + m * 16;
                float s2 = 0.f;
#pragma unroll
                for (int bj = 0; bj < 2; ++bj) {
                    const size_t off = (size_t)row * D + colb + bj * HALF;
                    const u32x4 xq = xw[m][bj];
                    f32x4 x0 = {bf_lo(xq.x), bf_hi(xq.x), bf_lo(xq.y), bf_hi(xq.y)}, x1 = {bf_lo(xq.z), bf_hi(xq.z), bf_lo(xq.w), bf_hi(xq.w)};
                    f32x4 v0 = acc[ai][bj][m][0], v1 = acc[ai][bj][m][1];
                    if (MODE == 0) { v0 = v0 * alpha; v1 = v1 * alpha; }
                    if (MODE == 1) { v0 = v0 * cs[bj][0]; v1 = v1 * cs[bj][1]; }
                    if (MODE >= 2) {
                        const u32x4 pq = pw[m][bj];
                        const f32x4 p0 = {bf_lo(pq.x), bf_hi(pq.x), bf_lo(pq.y), bf_hi(pq.y)}, p1 = {bf_lo(pq.z), bf_hi(pq.z), bf_lo(pq.w), bf_hi(pq.w)};
#pragma unroll
                        for (int e = 0; e < 4; ++e) { v0[e] = fast_sigmoid(v0[e] * rinv[m]) * p0[e]; v1[e] = fast_sigmoid(v1[e] * rinv[m]) * p1[e]; }
                    }
                    x0 = x0 + v0; x1 = x1 + v1;
                    if (MODE == 3) { *(f32x4*)(OUT + off) = x0; *(f32x4*)(OUT + off + 4) = x1; }
                    else *(u32x4*)(XW + off) = pack8(x0, x1);
                    s2 += (x0[0] * x0[0] + x0[1] * x0[1]) + (x0[2] * x0[2] + x0[3] * x0[3]) + (x1[0] * x1[0] + x1[1] * x1[1]) + (x1[2] * x1[2] + x1[3] * x1[3]);
                }
                s2 += shx(s2, fq * 16 + fr, 16); s2 += shx(s2, fq * 16 + fr, 32);
                if (MODE != 3 && fq == 0) ss_add(ss_next, row, s2);
            }
            asm volatile("" ::: "memory");
        }
    }
};
struct EpiNull {
    __device__ __forceinline__ void pre(ss_t (&pv)[8], const Unit& u, int wr, int fr) const {}
    __device__ __forceinline__ void operator()(const Acc& acc, const Unit& u, int wr, int wc, int fr, int fq, const ss_t (&pv)[8]) const {
#pragma unroll
        for (int a = 0; a < 2; ++a)
#pragma unroll
            for (int b = 0; b < 2; ++b)
#pragma unroll
                for (int m = 0; m < 4; ++m)
#pragma unroll
                    for (int n = 0; n < 2; ++n) asm volatile("" :: "v"(acc[a][b][m][n]));
    }
};
struct EpiQKV {
    const ss_t* ss; bf16_t* Q; const float* qg; const float* kg;
    __device__ __forceinline__ void pre(ss_t (&pv)[8], const Unit& u, int wr, int fr) const { ss_pre(pv, ss, u, wr, fr); }
    __device__ __forceinline__ void operator()(const Acc& acc, const Unit& u, int wr, int wc, int fr, int fq, const ss_t (&pv)[8]) const {
        const int which = u.pn >> 2, pnl = u.pn & 3;
        bf16_t* dst = Q + (size_t)which * M * D;
        const int row0 = u.pm * BM + wr * 64 + fr, colb = pnl * 256 + wc * 64 + 8 * fq;
        const float* gp = which == 0 ? qg : kg;
        f32x4 gn[2][2];
#pragma unroll
        for (int bj = 0; bj < 2; ++bj)
#pragma unroll
            for (int n = 0; n < 2; ++n) gn[bj][n] = *(const f32x4*)(gp + 32 * bj + 8 * fq + 4 * n);
        const float qs = which == 0 ? 0.125f : 1.0f;
#pragma unroll
        for (int ai = 0; ai < 2; ++ai)
#pragma unroll
            for (int m = 0; m < 4; ++m) {
                const int row = row0 + ai * HALF + m * 16;
                const float rinv = ss_rinv_v(pv[ai * 4 + m]);
                f32x4 v[2][2]; float s2 = 0.f;
#pragma unroll
                for (int bj = 0; bj < 2; ++bj)
#pragma unroll
                    for (int n = 0; n < 2; ++n) { v[bj][n] = acc[ai][bj][m][n] * rinv; const f32x4 t = v[bj][n]; s2 += (t[0] * t[0] + t[1] * t[1]) + (t[2] * t[2] + t[3] * t[3]); }
                s2 += shx(s2, fq * 16 + fr, 16); s2 += shx(s2, fq * 16 + fr, 32);
                if (which < 2) {
                    const float hr = rsqrtf(s2 * (1.0f / HD) + EPS) * qs;
#pragma unroll
                    for (int bj = 0; bj < 2; ++bj)
#pragma unroll
                        for (int n = 0; n < 2; ++n) v[bj][n] = v[bj][n] * hr * gn[bj][n];
                }
#pragma unroll
                for (int bj = 0; bj < 2; ++bj) *(u32x4*)(dst + (size_t)row * D + colb + 32 * bj) = pack8(v[bj][0], v[bj][1]);
            }
    }
};
template <bool RINV> struct EpiBf16S {
    const ss_t* ss; bf16_t* O; int ldc;
    __device__ __forceinline__ void pre(ss_t (&pv)[8], const Unit& u, int wr, int fr) const { if (RINV) ss_pre(pv, ss, u, wr, fr); }
    __device__ __forceinline__ void operator()(const Acc& acc, const Unit& u, int wr, int wc, int fr, int fq, const ss_t (&pv)[8]) const {
        const int row0 = u.pm * BM + wr * 64 + fr, colb = u.pn * BM + wc * 32 + 8 * fq;
#pragma unroll
        for (int ai = 0; ai < 2; ++ai)
#pragma unroll
            for (int m = 0; m < 4; ++m) {
                const int row = row0 + ai * HALF + m * 16;
                float rinv = 1.f; if (RINV) rinv = ss_rinv_v(pv[ai * 4 + m]);
#pragma unroll
                for (int bj = 0; bj < 2; ++bj) *(u32x4*)(O + (size_t)row * ldc + colb + bj * HALF) = pack8(acc[ai][bj][m][0] * rinv, acc[ai][bj][m][1] * rinv);
            }
    }
};

__device__ __forceinline__ void gemm_prefetch_b(LAS unsigned char* lds, const Gemm g, const StaticOrder& S, int wv) {
    int tid_ = wv * 64 + lane_id(); asm volatile("" : "+v"(tid_));
    const int tid = tid_, wid = __builtin_amdgcn_readfirstlane(tid >> 6);
    Unit cur; if (!S.next(0, cur)) return;
    const size_t hstepB = (size_t)HALF * g.ldb * 2; const char* cB = (const char*)g.Bt + (size_t)cur.pn * 2 * hstepB;
    const unsigned ldsw = (unsigned)wid * 1024u;
#pragma unroll
    for (int i = 0; i < 2; ++i) { int R, C; stage_rc(tid * 16 + i * 8192, R, C); const int Rb = (R & ~31) + perm32(R & 31); const unsigned vo = (unsigned)(Rb * g.ldb + C) * 2u;
#pragma unroll
        for (int b = 0; b < 2; ++b)
#pragma unroll
            for (int h = 0; h < 2; ++h)
                __builtin_amdgcn_global_load_lds((const unsigned*)(cB + (size_t)h * hstepB + (size_t)b * (BK * 2) + vo), (LAS unsigned*)(lds + (4 + b * 2 + h) * HTB + ldsw + i * 8192), 16, 0, 0);
    }
}

template <class Epi, bool ALIGN_EPI, bool BPRE = false>
__device__ __forceinline__ void gemm_phase(LAS unsigned char* lds, const Gemm g, const StaticOrder& S, const Epi& E, int wv) {
    int tid_ = wv * 64 + lane_id(); asm volatile("" : "+v"(tid_));
    const int tid = tid_, wid = __builtin_amdgcn_readfirstlane(tid >> 6), lane = tid & 63, wr = wid >> 2, wc = wid & 3, fr = lane & 15, fq = lane >> 4;
    const int K = g.K, nt = K / BK;
    unsigned voffA[2], voffB[2];
#pragma unroll
    for (int i = 0; i < 2; ++i) { int R, C; stage_rc(tid * 16 + i * 8192, R, C); const int Rb = (R & ~31) + perm32(R & 31);
        voffA[i] = (unsigned)(R * g.lda + C) * 2u; voffB[i] = (unsigned)(Rb * g.ldb + C) * 2u; }
    const size_t kstep = (size_t)(BK * 2);
    const size_t hstepA = (size_t)HALF * g.lda * 2, hstepB = (size_t)HALF * g.ldb * 2;
    const size_t tstepA = 2 * hstepA, tstepB = 2 * hstepB;
    const unsigned ldsw = (unsigned)wid * 1024u;
    const int aoff = lds_byte(wr * 64 + fr, fq * 8), boff = lds_byte(wc * 32 + fr, fq * 8);
#define PG8_SA(b, h) (((b) * 2 + (h)) * HTB)
#define PG8_SB(b, h) ((4 + (b) * 2 + (h)) * HTB)
#define PG8_STAGE(bufoff, gbase, voff) do { _Pragma("unroll") for (int _i = 0; _i < 2; ++_i) \
        __builtin_amdgcn_global_load_lds((const unsigned*)((const char*)(gbase) + (voff)[_i]), (LAS unsigned*)(lds + (bufoff) + ldsw + _i * 8192), 16, 0, 0); } while (0)
#define PG8_LDA(dst, b, h) do { _Pragma("unroll") for (int m = 0; m < 4; ++m) _Pragma("unroll") for (int k = 0; k < 2; ++k) dst[m][k] = *(const LAS bf16x8*)(lds + PG8_SA(b, h) + aoff + m * 2048 + k * 1024); } while (0)
#define PG8_LDB(dst, b, h) do { _Pragma("unroll") for (int n = 0; n < 2; ++n) _Pragma("unroll") for (int k = 0; k < 2; ++k) dst[n][k] = *(const LAS bf16x8*)(lds + PG8_SB(b, h) + boff + n * 2048 + k * 1024); } while (0)
#define PG8_MMA(ai, bj, At, Bt) do { __builtin_amdgcn_s_setprio(1); _Pragma("unroll") for (int m = 0; m < 4; ++m) _Pragma("unroll") for (int n = 0; n < 2; ++n) _Pragma("unroll") for (int k = 0; k < 2; ++k) \
        acc[ai][bj][m][n] = __builtin_amdgcn_mfma_f32_16x16x32_bf16(Bt[n][k], At[m][k], acc[ai][bj][m][n], 0, 0, 0); __builtin_amdgcn_s_setprio(0); } while (0)
#define PG8_WAIT_V(n) asm volatile("s_waitcnt vmcnt(" #n ")" ::: "memory")
#define PG8_WAIT_L(n) asm volatile("s_waitcnt lgkmcnt(" #n ")" ::: "memory")
#define PG8_BAR __builtin_amdgcn_s_barrier()
#define PG8_SCHED __builtin_amdgcn_sched_barrier(0)
    Unit cur, nxt; int ui = 0;
    if (!S.next(0, cur)) return;
    if (g.stagger > 0 && (S.nwg - S.c + S.G - 1) / S.G < (S.nwg + S.G - 1) / S.G) { const unsigned long long t0 = __builtin_amdgcn_s_memrealtime(); while (__builtin_amdgcn_s_memrealtime() - t0 < (unsigned long long)g.stagger) __builtin_amdgcn_s_sleep(16); }
    Acc acc;
#pragma unroll
    for (int a = 0; a < 2; ++a)
#pragma unroll
        for (int b = 0; b < 2; ++b)
#pragma unroll
            for (int m = 0; m < 4; ++m)
#pragma unroll
                for (int n = 0; n < 2; ++n) acc[a][b][m][n] = (f32x4){0.f, 0.f, 0.f, 0.f};
    bf16x8 At[4][2], B0[2][2], B1[2][2];
    ss_t pv[8];
#pragma unroll
    for (int i = 0; i < 8; ++i) pv[i] = 0;
    const char* cA = (const char*)g.A + (size_t)(cur.pm & g.umask) * tstepA + (size_t)(cur.pn & g.umask) * g.a_pn_off * 2; const char* cB = (const char*)g.Bt + (size_t)(cur.pn & g.umask) * tstepB;
    if constexpr (BPRE) {
        PG8_STAGE(PG8_SA(0, 0), cA, voffA); PG8_STAGE(PG8_SA(0, 1), cA + hstepA, voffA);
        if (wr == 1) PG8_BAR;
        PG8_WAIT_V(2); PG8_BAR;
        PG8_STAGE(PG8_SA(1, 0), cA + kstep, voffA);
        PG8_WAIT_V(2); PG8_BAR;
    } else {
    PG8_STAGE(PG8_SB(0, 0), cB, voffB); PG8_STAGE(PG8_SB(0, 1), cB + hstepB, voffB); PG8_STAGE(PG8_SA(0, 0), cA, voffA); PG8_STAGE(PG8_SA(0, 1), cA + hstepA, voffA);
    if (wr == 1) PG8_BAR;
    PG8_WAIT_V(2); PG8_BAR;
    PG8_STAGE(PG8_SB(1, 0), cB + kstep, voffB); PG8_STAGE(PG8_SA(1, 0), cA + kstep, voffA); PG8_STAGE(PG8_SB(1, 1), cB + hstepB + kstep, voffB);
    PG8_WAIT_V(6); PG8_BAR;
    }
    for (;;) {
        const bool has_next = S.next(ui + 1, nxt);
        const char* nA = has_next ? (const char*)g.A + (size_t)(nxt.pm & g.umask) * tstepA + (size_t)(nxt.pn & g.umask) * g.a_pn_off * 2 : cA; const char* nB = has_next ? (const char*)g.Bt + (size_t)(nxt.pn & g.umask) * tstepB : cB;
        for (int t = 0; t < nt; t += 2) {
            const bool last = (t == nt - 2);
            if (last) E.pre(pv, cur, wr, lane_id() & 15);
            const char* a1 = cA + (size_t)(t + 1) * kstep;
            const char* a2 = last ? nA : cA + (size_t)(t + 2) * kstep; const char* b2 = last ? nB : cB + (size_t)(t + 2) * kstep;
            const char* a3 = a2 + kstep; const char* b3 = b2 + kstep;
            PG8_LDB(B0, 0, 0); PG8_LDB(B1, 0, 1); PG8_SCHED; PG8_LDA(At, 0, 0); PG8_STAGE(PG8_SA(1, 1), a1 + hstepA, voffA);
            PG8_WAIT_V(8); PG8_WAIT_L(0); PG8_BAR; PG8_MMA(0, 0, At, B0); PG8_MMA(0, 1, At, B1); PG8_BAR; PG8_SCHED;
            PG8_LDA(At, 0, 1); PG8_STAGE(PG8_SB(0, 0), b2, voffB); PG8_STAGE(PG8_SB(0, 1), b2 + hstepB, voffB); PG8_STAGE(PG8_SA(0, 0), a2, voffA);
            PG8_WAIT_V(8); PG8_WAIT_L(0); PG8_BAR; PG8_MMA(1, 0, At, B0); PG8_MMA(1, 1, At, B1); PG8_BAR; PG8_SCHED;
            PG8_LDB(B0, 1, 0); PG8_LDB(B1, 1, 1); PG8_SCHED; PG8_LDA(At, 1, 0); PG8_STAGE(PG8_SA(0, 1), a2 + hstepA, voffA);
            PG8_WAIT_V(8); PG8_WAIT_L(0); PG8_BAR; PG8_MMA(0, 0, At, B0); PG8_MMA(0, 1, At, B1); PG8_BAR; PG8_SCHED;
            PG8_LDA(At, 1, 1); PG8_STAGE(PG8_SB(1, 0), b3, voffB); PG8_STAGE(PG8_SB(1, 1), b3 + hstepB, voffB); PG8_STAGE(PG8_SA(1, 0), a3, voffA);
            PG8_WAIT_V(8); PG8_WAIT_L(0); PG8_BAR; PG8_MMA(1, 0, At, B0); PG8_MMA(1, 1, At, B1); PG8_BAR; PG8_SCHED;
        }
        if constexpr (ALIGN_EPI) { if (wr == 0) PG8_BAR; }
        _Pragma("unroll 1") for (int er_ = 0; er_ < g.epi_rep; ++er_) { const int l2 = lane_id(); E(acc, cur, wr, wc, l2 & 15, l2 >> 4, pv); }
        if (!has_next) break;
#pragma unroll
        for (int a = 0; a < 2; ++a)
#pragma unroll
            for (int b = 0; b < 2; ++b)
#pragma unroll
                for (int m = 0; m < 4; ++m)
#pragma unroll
                    for (int n = 0; n < 2; ++n) acc[a][b][m][n] = (f32x4){0.f, 0.f, 0.f, 0.f};
        cur = nxt; cA = nA; cB = nB; ++ui;
        if constexpr (ALIGN_EPI) { if (wr == 1) PG8_BAR; }
    }
    PG8_WAIT_V(0);
    if constexpr (!ALIGN_EPI) { if (wr == 0) PG8_BAR; }
    PG8_BAR;
#undef PG8_SA
#undef PG8_SB
#undef PG8_STAGE
#undef PG8_LDA
#undef PG8_LDB
#undef PG8_MMA
#undef PG8_WAIT_V
#undef PG8_WAIT_L
#undef PG8_BAR
#undef PG8_SCHED
}
}

__device__ __forceinline__ unsigned f2bf(float f) { unsigned u = __builtin_bit_cast(unsigned, f); return (u + 0x7fffu + ((u >> 16) & 1u)) >> 16; }
__device__ __forceinline__ unsigned pk2(float lo, float hi) { return f2bf(lo) | (f2bf(hi) << 16); }
__device__ __forceinline__ float wave_sum(float v, int lane) {
#pragma unroll
    for (int o = 1; o < 64; o <<= 1) v += shx(v, lane, o);
    return v;
}
template <int MAP> __device__ __forceinline__ int map_row(int n0) {
    if (MAP == 1) { const int up = n0 >= DFF ? 1 : 0, j = n0 - up * DFF; return 256 * (j >> 7) + 128 * up + (j & 127); }
    if (MAP == 2) { const int pn = n0 >> 8, r = n0 & 255, wc = r >> 6, bj = (r >> 5) & 1; return 256 * pn + 128 * bj + 32 * wc; }
    return n0;
}
template <int MAP> __device__ __forceinline__ void conv_item(const float* W, int K, int N, bf16_t* WT, const float* gain, LAS float* scr, int item, int lane) {
    const int nblk = N / 64, kb = item / nblk, nb = item % nblk, k0 = 64 * kb, n0 = 64 * nb;
    const int c4 = lane & 15, kr = lane >> 4;
    f32x4 v[16];
#pragma unroll
    for (int i = 0; i < 16; ++i) v[i] = *(const f32x4*)(W + (size_t)(k0 + 4 * i + kr) * N + n0 + 4 * c4);
    if (gain) {
#pragma unroll
        for (int i = 0; i < 16; ++i) v[i] = v[i] * gain[k0 + 4 * i + kr];
    }
#pragma unroll
    for (int i = 0; i < 16; ++i) { const int kk = 4 * i + kr; LAS float* t = scr + (4 * c4) * 65 + kk; t[0] = v[i][0]; t[65] = v[i][1]; t[130] = v[i][2]; t[195] = v[i][3]; }
    asm volatile("s_waitcnt lgkmcnt(0)" ::: "memory");
    const int c = lane & 7, nr = lane >> 3;
#pragma unroll
    for (int j = 0; j < 8; ++j) { const int n = nr + 8 * j; const LAS float* t = scr + n * 65 + 8 * c;
        u32x4 o; o.x = pk2(t[0], t[1]); o.y = pk2(t[2], t[3]); o.z = pk2(t[4], t[5]); o.w = pk2(t[6], t[7]);
        const int r = map_row<MAP>(n0 + (n & 32)) + (n & 31);
        *(u32x4*)(WT + (size_t)r * K + k0 + 8 * c) = o; }
    asm volatile("s_waitcnt lgkmcnt(0)" ::: "memory");
}

__device__ __forceinline__ int lane_id() { int l; asm volatile("v_mbcnt_lo_u32_b32 %0, -1, 0\n\tv_mbcnt_hi_u32_b32 %0, -1, %0" : "=v"(l)); return l; }
__device__ __forceinline__ int opaque_int(int v) { asm volatile("" : "+s"(v)); return v; }
__device__ __forceinline__ unsigned char* opaque_ptr(unsigned char* p) { unsigned z = 0; asm volatile("" : "+s"(z)); return p + z; }
struct Args { const float* in[19]; float* out; unsigned char* ws; int ph_lo, ph_hi; };

template <int MAP> __device__ __forceinline__ void conv_mat(const float* W, int K, int N, bf16_t* WT, const float* gain, LAS float* scr, int gw, int NGW, int& off, int lane) {
    const int nitems = (K / 64) * (N / 64);
    int start = gw - off; if (start < 0) start += NGW;
    for (int it = start; it < nitems; it += NGW) conv_item<MAP>(W, K, N, WT, gain, scr, it, lane);
    off = (off + nitems) % NGW;
}

__device__ __forceinline__ void prologue(const Args& a, LAS unsigned char* lds, int G) {
    const int tid = threadIdx.x, lane = tid & 63, wave = tid >> 6;
    const int gw = blockIdx.x * 8 + wave, NGW = G * 8;
    unsigned char* ws = a.ws;
    { unsigned* ss = (unsigned*)(ws + WS_SS) + M; const int n4 = 16 * M / 4;
      for (int i = blockIdx.x * 512 + tid; i < n4; i += G * 512) ((f32x4*)ss)[i] = (f32x4){0.f, 0.f, 0.f, 0.f}; }
    { unsigned* ss0 = (unsigned*)(ws + WS_SS); bf16_t* xb = (bf16_t*)(ws + WS_XB);
      for (int m0 = gw; m0 < M; m0 += 4 * NGW) {
          f32x4 v[4][4];
#pragma unroll
          for (int r = 0; r < 4; ++r) { const int m = m0 + r * NGW; if (m < M) { const f32x4* xr = (const f32x4*)(a.in[0] + (size_t)m * D) + lane;
#pragma unroll
              for (int j = 0; j < 4; ++j) v[r][j] = xr[64 * j]; } }
#pragma unroll
          for (int r = 0; r < 4; ++r) { const int m = m0 + r * NGW; if (m < M) { u32x2* brow = (u32x2*)(xb + (size_t)m * D) + lane; float s = 0.f;
#pragma unroll
              for (int j = 0; j < 4; ++j) { const f32x4 q = v[r][j]; u32x2 w; w.x = pk2(q[0], q[1]); w.y = pk2(q[2], q[3]); brow[64 * j] = w; s += (q[0] * q[0] + q[1] * q[1]) + (q[2] * q[2] + q[3] * q[3]); }
              s = wave_sum(s, lane); if (lane == 0) ss0[m] = __float2uint_rn(s * pg8::SS_SCALE); } }
      } }
    const bool defer = G == 256;
    if (!defer) { const f32x4* p4 = (const f32x4*)a.in[1]; u32x4* pb = (u32x4*)(ws + WS_PB); const int n8 = DEPTH * M * PLE / 8;
      for (int i = blockIdx.x * 512 + tid; i < n8; i += G * 512) { const f32x4 v0 = p4[2 * i], v1 = p4[2 * i + 1]; u32x4 w; w.x = pk2(v0[0], v0[1]); w.y = pk2(v0[2], v0[3]); w.z = pk2(v1[0], v1[1]); w.w = pk2(v1[2], v1[3]); pb[i] = w; } }
    LAS float* scr = (LAS float*)(lds + wave * 16640);
    int off = 0;
#pragma unroll 1
    for (int l = 0; l < DEPTH; ++l) {
        conv_mat<1>(a.in[3] + (size_t)l * D * 2 * DFF, D, 2 * DFF, (bf16_t*)(ws + WS_WGU + (size_t)(2 * l) * SZ_WGU), a.in[2] + l * D, scr, gw, NGW, off, lane);
        conv_mat<1>(a.in[14] + (size_t)l * D * 2 * DFF, D, 2 * DFF, (bf16_t*)(ws + WS_WGU + (size_t)(2 * l + 1) * SZ_WGU), a.in[13] + l * D, scr, gw, NGW, off, lane);
        conv_mat<0>(a.in[4] + (size_t)l * DFF * D, DFF, D, (bf16_t*)(ws + WS_WDN + (size_t)(2 * l) * SZ_WDN), nullptr, scr, gw, NGW, off, lane);
        conv_mat<0>(a.in[15] + (size_t)l * DFF * D, DFF, D, (bf16_t*)(ws + WS_WDN + (size_t)(2 * l + 1) * SZ_WDN), nullptr, scr, gw, NGW, off, lane);
        conv_mat<0>(a.in[17] + (size_t)l * D * D, D, D, (bf16_t*)(ws + WS_WGATE + (size_t)l * SZ_WDD), a.in[16] + l * D, scr, gw, NGW, off, lane);
        conv_mat<0>(a.in[18] + (size_t)l * PLE * D, PLE, D, (bf16_t*)(ws + WS_WPROJ + (size_t)l * SZ_WPROJ), nullptr, scr, gw, NGW, off, lane);
    }
#pragma unroll 1
    for (int j = 0; j < 2; ++j) {
        conv_mat<2>(a.in[6] + (size_t)j * D * 3 * D, D, 3 * D, (bf16_t*)(ws + WS_WQKV + (size_t)j * SZ_WQKV), a.in[5] + (2 * j) * D, scr, gw, NGW, off, lane);
        conv_mat<0>(a.in[9] + (size_t)j * D * D, D, D, (bf16_t*)(ws + WS_WO + (size_t)j * SZ_WDD), nullptr, scr, gw, NGW, off, lane);
        conv_mat<0>(a.in[10] + (size_t)j * D * D, D, D, (bf16_t*)(ws + WS_WIN + (size_t)j * SZ_WDD), a.in[5] + (2 * j + 1) * D, scr, gw, NGW, off, lane);
#pragma unroll 1
        for (int g = 0; g < 4; ++g)
            conv_mat<0>(a.in[11] + (size_t)(j * 4 + g) * 256 * 256, 256, 256, (bf16_t*)(ws + WS_WGRP + (size_t)j * SZ_WGRP + (size_t)g * 256 * 256 * 2), nullptr, scr, gw, NGW, off, lane);
    }
}

__device__ __forceinline__ void unpack8(const u32x4 w, float* f) {
    f[0] = pg8::bf_lo(w.x); f[1] = pg8::bf_hi(w.x); f[2] = pg8::bf_lo(w.y); f[3] = pg8::bf_hi(w.y); f[4] = pg8::bf_lo(w.z); f[5] = pg8::bf_hi(w.z); f[6] = pg8::bf_lo(w.w); f[7] = pg8::bf_hi(w.w);
}
template <int W> __device__ __forceinline__ void pool_strip(const bf16_t* up, bf16_t* pp, int t0) {
    constexpr int NR = 15 + W;
    u32x4 raw[NR];
#pragma unroll
    for (int j = 0; j < NR; ++j) { const int dj = j - (W - 1); raw[j] = (t0 + dj >= 0) ? *(const u32x4*)(up + (ptrdiff_t)dj * D) : (u32x4){0u, 0u, 0u, 0u}; }
    float S[8];
#pragma unroll
    for (int e = 0; e < 8; ++e) S[e] = 0.f;
#pragma unroll
    for (int j = 0; j < W - 1; ++j) { float f[8]; unpack8(raw[j], f);
#pragma unroll
        for (int e = 0; e < 8; ++e) S[e] += f[e]; }
#pragma unroll
    for (int r = 0; r < 16; ++r) {
        float cur[8]; unpack8(raw[r + W - 1], cur);
        const int t = t0 + r; const float ic = 1.0f / (float)(t + 1 < W ? t + 1 : W); float o[8];
#pragma unroll
        for (int e = 0; e < 8; ++e) { S[e] += cur[e]; o[e] = S[e] * ic - cur[e]; }
        u32x4 ow; ow.x = pk2(o[0], o[1]); ow.y = pk2(o[2], o[3]); ow.z = pk2(o[4], o[5]); ow.w = pk2(o[6], o[7]);
        *(u32x4*)(pp + (ptrdiff_t)r * D) = ow;
        float old[8]; unpack8(raw[r], old);
#pragma unroll
        for (int e = 0; e < 8; ++e) S[e] -= old[e];
    }
}
__device__ __forceinline__ void pool_phase(const bf16_t* U, bf16_t* P, int G, int wv) {
    int lane_ = lane_id(); asm volatile("" : "+v"(lane_));
    const int lane = lane_;
    for (int it = blockIdx.x * 8 + wv; it < (M / 32) * 4; it += G * 8) {
        const int grp = it & 3, sp = it >> 2, strip = 2 * sp + (lane >> 5), chunk = grp * 32 + (lane & 31), row0 = strip * 16, t0 = row0 & (SEQ - 1);
        const bf16_t* up = U + (size_t)row0 * D + chunk * 8; bf16_t* pp = P + (size_t)row0 * D + chunk * 8;
        if (grp == 0) pool_strip<2>(up, pp, t0); else if (grp == 1) pool_strip<4>(up, pp, t0); else if (grp == 2) pool_strip<8>(up, pp, t0); else pool_strip<16>(up, pp, t0);
    }
}

__device__ __forceinline__ void pool_unit(const bf16_t* U, bf16_t* P, int pm, int pn, int wv) {
    int lane_ = lane_id(); asm volatile("" : "+v"(lane_));
    const int tid = wv * 64 + lane_, strip = pm * 16 + (tid >> 5), chunk = pn * 32 + (tid & 31), row0 = strip * 16, t0 = row0 & (SEQ - 1);
    const bf16_t* up = U + (size_t)row0 * D + chunk * 8; bf16_t* pp = P + (size_t)row0 * D + chunk * 8;
    if (pn == 0) pool_strip<2>(up, pp, t0); else if (pn == 1) pool_strip<4>(up, pp, t0); else if (pn == 2) pool_strip<8>(up, pp, t0); else pool_strip<16>(up, pp, t0);
}

__device__ __forceinline__ void attn_phase(LAS unsigned char* lds, const bf16_t* Q, const bf16_t* Kg, const bf16_t* Vg, bf16_t* O, int G, int wv) {
    LAS bf16_t* Ks0 = (LAS bf16_t*)lds;
    LAS bf16_t* Vt0 = (LAS bf16_t*)(lds + 2 * 9216);
    LAS unsigned* flags0 = (LAS unsigned*)(lds + 2 * 9216 + 2 * 8704);
    int par = 0;
    int tid_ = wv * 64 + lane_id(); asm volatile("" : "+v"(tid_));
    const int tid = tid_, wid = tid >> 6, lane = tid & 63, l16 = lane & 15, g = lane >> 4;
    constexpr int NU = 2 * NH * (SEQ / 128);
    const int key = tid >> 3, dc = tid & 7;
    bf16x8 qf[2]; u32x4 kv, vv;
    if ((int)blockIdx.x < NU) { const int unit = blockIdx.x, qblk = unit & 63, bh = unit >> 6, b = bh >> 4, h = bh & 15; const size_t rowbase = (size_t)b * SEQ;
        const bf16_t* qp = Q + (rowbase + qblk * 128 + wid * 16 + l16) * D + h * HD + 8 * g; qf[0] = *(const bf16x8*)qp; qf[1] = *(const bf16x8*)(qp + 32);
        const size_t src = (rowbase + key) * D + h * HD + 8 * dc + (size_t)(2 * qblk + 1) * 64 * D; kv = *(const u32x4*)(Kg + src); vv = *(const u32x4*)(Vg + src); }
    for (int unit = blockIdx.x; unit < NU; unit += G) {
        const int qblk = unit & 63, bh = unit >> 6, b = bh >> 4, h = bh & 15;
        const size_t rowbase = (size_t)b * SEQ; const int t0 = qblk * 128 + wid * 16, tq = t0 + l16;
        const bool has_next = unit + G < NU;
        bf16x8 qn[2]; u32x4 kvn, vvn;
        if (has_next) { const int un = unit + G, qb2 = un & 63, bh2 = un >> 6, b2 = bh2 >> 4, h2 = bh2 & 15; const size_t rb2 = (size_t)b2 * SEQ;
            const bf16_t* qp = Q + (rb2 + qb2 * 128 + wid * 16 + l16) * D + h2 * HD + 8 * g; qn[0] = *(const bf16x8*)qp; qn[1] = *(const bf16x8*)(qp + 32);
            const size_t src = (rb2 + key) * D + h2 * HD + 8 * dc + (size_t)(2 * qb2 + 1) * 64 * D; kvn = *(const u32x4*)(Kg + src); vvn = *(const u32x4*)(Vg + src); }
        f32x4 o[4];
#pragma unroll
        for (int i = 0; i < 4; ++i) o[i] = (f32x4){0.f, 0.f, 0.f, 0.f};
        float carry = 1.f; unsigned wave_done = 0u;
        const size_t srcb = (rowbase + key) * D + h * HD + 8 * dc;
        for (int kt = 2 * qblk + 1; kt >= 0; --kt) {
            LAS bf16_t* Ks = Ks0 + par * (64 * 72); LAS bf16_t* Vt = Vt0 + par * (64 * 68); LAS unsigned* flags = flags0 + par * 8; par ^= 1;
            if (lane == 0) flags[wid] = wave_done;
            { *(LAS u32x4*)(Ks + key * 72 + 8 * dc) = kv;
              LAS bf16_t* vd = Vt + (8 * dc) * 68 + key;
              vd[0 * 68] = (bf16_t)(vv.x & 0xffffu); vd[1 * 68] = (bf16_t)(vv.x >> 16); vd[2 * 68] = (bf16_t)(vv.y & 0xffffu); vd[3 * 68] = (bf16_t)(vv.y >> 16);
              vd[4 * 68] = (bf16_t)(vv.z & 0xffffu); vd[5 * 68] = (bf16_t)(vv.z >> 16); vd[6 * 68] = (bf16_t)(vv.w & 0xffffu); vd[7 * 68] = (bf16_t)(vv.w >> 16); }
            __syncthreads();
            unsigned all = 1u;
#pragma unroll
            for (int i = 0; i < 8; ++i) all &= flags[i];
            if (all) break;
            if (kt > 0) { const size_t src = srcb + (size_t)(kt - 1) * 64 * D; kv = *(const u32x4*)(Kg + src); vv = *(const u32x4*)(Vg + src); }
            if (!wave_done && kt * 64 <= t0 + 14) {
                f32x4 z[4];
#pragma unroll
                for (int bb = 0; bb < 4; ++bb) { z[bb] = (f32x4){0.f, 0.f, 0.f, 0.f};
#pragma unroll
                    for (int ks = 0; ks < 2; ++ks) { const bf16x8 ka = *(const LAS bf16x8*)(Ks + (16 * bb + l16) * 72 + 32 * ks + 8 * g); z[bb] = __builtin_amdgcn_mfma_f32_16x16x32_bf16(ka, qf[ks], z[bb], 0, 0, 0); } }
                f32x2 st[4][2], be[4][2]; float tot[4], Ex[4];
                const bool diag = kt * 64 + 63 >= t0;
#pragma unroll
                for (int bb = 0; bb < 4; ++bb) {
#pragma unroll
                    for (int h = 0; h < 2; ++h) {
                        const f32x2 t = (f32x2){z[bb][2 * h], z[bb][2 * h + 1]} * 1.44269504089f;
                        f32x2 e; e.x = __builtin_amdgcn_exp2f(t.x); e.y = __builtin_amdgcn_exp2f(t.y);
                        const f32x2 d = e + 1.0f;
                        f32x2 r; r.x = __builtin_amdgcn_rcpf(d.x); r.y = __builtin_amdgcn_rcpf(d.y);
                        f32x2 b_ = 1.0f - r;
                        if (diag) { const int s = kt * 64 + 16 * bb + 4 * g + 2 * h;
                            if (!(s < tq)) { r.x = 1.f; b_.x = 0.f; }
                            if (!(s + 1 < tq)) { r.y = 1.f; b_.y = 0.f; } }
                        st[bb][h] = r; be[bb][h] = b_;
                    }
                    const f32x2 pp = st[bb][0] * st[bb][1]; const float T = pp.x * pp.y;
                    const float a_ = shx(T, lane, 16), b2 = T * a_, c_ = shx(b2, lane, 32);
                    tot[bb] = b2 * c_; Ex[bb] = ((g & 1) == 0 ? a_ : 1.f) * ((g & 2) == 0 ? c_ : 1.f);
                }
                float wv[4][4]; float right = carry;
#pragma unroll
                for (int bb = 3; bb >= 0; --bb) {
                    const float base = right * Ex[bb];
                    const float p2 = st[bb][1].y, p1 = p2 * st[bb][1].x, p0 = p1 * st[bb][0].y;
                    const f32x2 w1 = (be[bb][1] * (f32x2){p2, 1.f}) * base, w0 = (be[bb][0] * (f32x2){p0, p1}) * base;
                    wv[bb][0] = w0.x; wv[bb][1] = w0.y; wv[bb][2] = w1.x; wv[bb][3] = w1.y;
                    right *= tot[bb];
                }
                carry = right;
#pragma unroll
                for (int c = 0; c < 2; ++c) {
                    u32x4 pw; pw.x = pg8::cvt_pk_bf16(wv[2 * c][0], wv[2 * c][1]); pw.y = pg8::cvt_pk_bf16(wv[2 * c][2], wv[2 * c][3]);
                    pw.z = pg8::cvt_pk_bf16(wv[2 * c + 1][0], wv[2 * c + 1][1]); pw.w = pg8::cvt_pk_bf16(wv[2 * c + 1][2], wv[2 * c + 1][3]);
                    const bf16x8 pbf = __builtin_bit_cast(bf16x8, pw);
#pragma unroll
                    for (int db = 0; db < 4; ++db) {
                        const LAS bf16_t* vp = Vt + (16 * db + l16) * 68 + 32 * c + 4 * g;
                        const u32x2 v0 = *(const LAS u32x2*)vp, v1 = *(const LAS u32x2*)(vp + 16);
                        u32x4 va; va.x = v0.x; va.y = v0.y; va.z = v1.x; va.w = v1.y;
                        o[db] = __builtin_amdgcn_mfma_f32_16x16x32_bf16(__builtin_bit_cast(bf16x8, va), pbf, o[db], 0, 0, 0);
                    }
                }
                wave_done = (__builtin_amdgcn_ballot_w64(carry < 1e-37f) == ~0ull) ? 1u : 0u;
            }
        }
        { bf16_t* op = O + (rowbase + tq) * D + h * HD + 4 * g;
#pragma unroll
          for (int db = 0; db < 4; ++db) { u32x2 w; w.x = pg8::cvt_pk_bf16(o[db][0], o[db][1]); w.y = pg8::cvt_pk_bf16(o[db][2], o[db][3]); *(u32x2*)(op + 16 * db) = w; } }
        if (has_next) { qf[0] = qn[0]; qf[1] = qn[1]; kv = kvn; vv = vvn; }
    }
    __syncthreads();
}

#define XB_TMO      128
#define XB_XCNT(j)  (256  + 64 * (j))
#define XB_XSUB(j)  (1280 + 64 * (j))
#define XB_XGEN(j)  (2304 + 64 * (j))
#define XB_TOP      3328
#define XB_TOPGEN   3392
#define XCD_BAR_WORDS 3456
#define XB_SPIN_CAP (1u << 18)
__device__ __forceinline__ unsigned xb_ld(unsigned* p)              { return __hip_atomic_load(p, __ATOMIC_RELAXED, __HIP_MEMORY_SCOPE_AGENT); }
__device__ __forceinline__ unsigned xb_add(unsigned* p, unsigned v) { return __hip_atomic_fetch_add(p, v, __ATOMIC_RELAXED, __HIP_MEMORY_SCOPE_AGENT); }
__device__ __forceinline__ unsigned xb_xcc_id() { return (unsigned)__builtin_amdgcn_s_getreg((3 << 11) | 20) & 0xFu; }
#define XB_SPIN(cond, bar) do { unsigned _sp = 0; while (cond) { __builtin_amdgcn_s_sleep(1); \
    if ((++_sp & 255u) == 0u) { if (xb_ld(&(bar)[XB_TMO])) break; if (_sp > XB_SPIN_CAP) { atomicAdd(&(bar)[XB_TMO], 1u); break; } } } } while (0)
struct XcdBarrier { unsigned* bar; unsigned x; volatile LAS unsigned* st; };
__device__ __forceinline__ XcdBarrier xcd_barrier_post(unsigned* bar, volatile LAS unsigned* st) {
    XcdBarrier b; b.bar = bar; b.x = xb_xcc_id(); b.st = st;
    if (threadIdx.x == 0) (void)xb_add(&bar[XB_XCNT(b.x)], 1u);
    return b;
}
__device__ __forceinline__ void xcd_barrier_complete(unsigned* bar, unsigned x, unsigned& nloc, unsigned& nx) {
    const unsigned G = gridDim.x * gridDim.y * gridDim.z;
    unsigned sum, cnt, mine, sp = 0u;
    for (;;) {
        sum = 0u; cnt = 0u; mine = 0u;
#pragma unroll
        for (unsigned j = 0; j < 16; ++j) { const unsigned c = xb_ld(&bar[XB_XCNT(j)]); sum += c; cnt += (c > 0u) ? 1u : 0u; mine = (j == x) ? c : mine; }
        if (sum == G) break;
        __builtin_amdgcn_s_sleep(1);
        if ((++sp & 255u) == 0u) { if (xb_ld(&bar[XB_TMO])) break; if (sp > XB_SPIN_CAP) { atomicAdd(&bar[XB_TMO], 1u); break; } }
    }
    nloc = mine > 0u ? mine : 1u; nx = cnt > 0u ? cnt : 1u;
}
__device__ __forceinline__ void xcd_barrier(const XcdBarrier& b, int wv) {
    asm volatile("s_waitcnt vmcnt(0)" ::: "memory");
    __syncthreads();
    if (opaque_int(wv) == 0) { if (lane_id() == 0) {
        unsigned* bar = (unsigned*)opaque_ptr((unsigned char*)b.bar);
        __builtin_amdgcn_s_waitcnt(0);
        unsigned nloc = b.st[0], nx = b.st[1];
        if (nloc == 0u) { xcd_barrier_complete(bar, b.x, nloc, nx); b.st[0] = nloc; b.st[1] = nx; }
        const unsigned old = xb_add(&bar[XB_XSUB(b.x)], 1u);
        const unsigned gen = old / nloc;
        if (old + 1u == (gen + 1u) * nloc) {
            __builtin_amdgcn_fence(__ATOMIC_RELEASE, "agent");
            asm volatile("s_waitcnt vmcnt(0)" ::: "memory");
            const unsigned og = xb_add(&bar[XB_TOP], 1u);
            const unsigned tg = og / nx;
            if (og + 1u == (tg + 1u) * nx) xb_add(&bar[XB_TOPGEN], 1u);
            else XB_SPIN(xb_ld(&bar[XB_TOPGEN]) == tg, bar);
            __builtin_amdgcn_fence(__ATOMIC_ACQUIRE, "agent");
            xb_add(&bar[XB_XGEN(b.x)], 1u);
            asm volatile("s_waitcnt vmcnt(0)" ::: "memory");
        } else {
            XB_SPIN(xb_ld(&bar[XB_XGEN(b.x)]) == gen, bar);
            __builtin_amdgcn_fence(__ATOMIC_ACQUIRE, "agent");
            asm volatile("s_waitcnt vmcnt(0)" ::: "memory");
        }
    } }
    __syncthreads();
}

__global__ void __launch_bounds__(512, 2) fwd_kernel(Args a) {
    extern __shared__ __attribute__((aligned(16))) unsigned char lds_raw[];
    LAS unsigned char* lds = (LAS unsigned char*)lds_raw;
    const int G0 = gridDim.x, bid0 = blockIdx.x, wv = __builtin_amdgcn_readfirstlane(threadIdx.x >> 6);
    unsigned char* ws0 = a.ws; float* X = a.out;
    volatile LAS unsigned* bst = (volatile LAS unsigned*)(lds + LDS_BYTES - 64);
    if (threadIdx.x < 2) bst[threadIdx.x] = 0u;
    __syncthreads();
    XcdBarrier xbar; xbar.bar = (unsigned*)(ws0 + WS_BAR); xbar.x = 0; xbar.st = bst;
#define REP(bit) _Pragma("unroll 1") for (int rep_ = 0, nrep_ = opaque_int((DUP_MASK & (bit)) ? 2 : 1); rep_ < nrep_; ++rep_)
#define OPQ() unsigned char* ws = opaque_ptr(ws0); const int G = opaque_int(G0), bid = opaque_int(bid0); pg8::ss_t* SS = (pg8::ss_t*)(ws + WS_SS); bf16_t* XB = (bf16_t*)(ws + ((l & 1) ? WS_XB2 : WS_XB)); bf16_t* XBN = (bf16_t*)(ws + ((l & 1) ? WS_XB : WS_XB2)); bf16_t* R1 = (bf16_t*)(ws + WS_R1); \
        bf16_t* ACT = R1; bf16_t* Qb = R1; bf16_t* Kb = R1 + (size_t)M * D; bf16_t* Vb = R1 + (size_t)2 * M * D; bf16_t* Ob = R1 + (size_t)3 * M * D; bf16_t* Ub = R1; bf16_t* PLb = R1 + (size_t)M * D; bf16_t* PE = (bf16_t*)(ws + WS_PE); \
        (void)SS; (void)XB; (void)XBN; (void)ACT; (void)Qb; (void)Kb; (void)Vb; (void)Ob; (void)Ub; (void)PLb; (void)PE; (void)G; (void)bid
#define SEAM() xcd_barrier(xbar, wv)
#define GEMM_SEAM(first) do { pg8::gemm_prefetch_b(lds, g, S, wv); if (first) { asm volatile("s_waitcnt vmcnt(0)" ::: "memory"); __syncthreads(); } else SEAM(); } while (0)
    xbar = xcd_barrier_post((unsigned*)(ws0 + WS_BAR), bst);
    prologue(a, lds, G0);
    __syncthreads();
    if (a.ph_lo != 0) cg::this_grid().sync();
#pragma unroll 1
    for (int l = 0; l < DEPTH; ++l) {
        const int j = l >> 1; const bool is_attn = (l & 1) == 0;
        pg8::StaticOrder S;
#pragma unroll 1
        for (int f = 0; f < 2; ++f) {
            {
                OPQ();
                pg8::Gemm g{XB, (const bf16_t*)(ws + WS_WGU + (size_t)(2 * l + f) * SZ_WGU), D, D, D, 0, 0, 1}; S.init(M, 2 * DFF, G, bid);
                pg8::EpiGU E{SS + (size_t)(4 * l + 2 * f) * M, ACT};
                GEMM_SEAM(false);
                pg8::gemm_phase<pg8::EpiGU, true, true>(lds, g, S, E, wv);
                if (DUP_MASK & 8) { pg8::gemm_phase<pg8::EpiGU, true, false>(lds, g, S, E, wv); }
                if (DUP_MASK & 2048) { pg8::EpiNull EN; pg8::gemm_phase<pg8::EpiNull, true, false>(lds, g, S, EN, wv); }
                if (DUP_MASK & 4096) { pg8::EpiNull EN; pg8::Gemm gp = g; gp.umask = opaque_int(0); pg8::gemm_phase<pg8::EpiNull, true, false>(lds, gp, S, EN, wv); }
                if (f == 0 && G == 256 && bid >= 128) {
                    const int tid2 = wv * 64 + lane_id(), sb = bid - 128;
                    const f32x4* p4 = (const f32x4*)(a.in[1] + (size_t)l * M * PLE); u32x4* pb = (u32x4*)(ws + WS_PB + (size_t)l * M * PLE * 2); const int n8 = M * PLE / 8;
                    for (int i = sb * 512 + tid2; i < n8; i += 128 * 512) { const f32x4 v0 = p4[2 * i], v1 = p4[2 * i + 1]; u32x4 w; w.x = pk2(v0[0], v0[1]); w.y = pk2(v0[2], v0[3]); w.z = pk2(v1[0], v1[1]); w.w = pk2(v1[2], v1[3]); pb[i] = w; }
                }
                if (f == 1 && G == 256 && bid >= 128) {
                    pg8::Gemm g2{(const bf16_t*)(ws + WS_PB) + (size_t)l * M * PLE, (const bf16_t*)(ws + WS_WPROJ + (size_t)l * SZ_WPROJ), PLE, PLE, PLE, 0, 0, 1}; pg8::StaticOrder S2; S2.init(M, D, 128, bid - 128);
                    pg8::EpiBf16S<false> E2{nullptr, PE, D};
                    pg8::gemm_phase<pg8::EpiBf16S<false>, false, false>(lds, g2, S2, E2, wv);
                }
            }
            {
                OPQ();
                pg8::Gemm g{ACT, (const bf16_t*)(ws + WS_WDN + (size_t)(2 * l + f) * SZ_WDN), DFF, DFF, DFF, 0, 0, 1}; S.init(M, D, G, bid);
                pg8::EpiRes<0> E{XB, XB, nullptr, SS + (size_t)(4 * l + 2 * f + 1) * M, 0.5f, nullptr, nullptr, nullptr};
                GEMM_SEAM(false);
                pg8::gemm_phase<pg8::EpiRes<0>, false, true>(lds, g, S, E, wv);
            }
            if (f == 0) {
                if (is_attn) {
                    { OPQ();
                      pg8::Gemm g{XB, (const bf16_t*)(ws + WS_WQKV + (size_t)j * SZ_WQKV), D, D, D, 0, 0, 1}; S.init(M, 3 * D, G, bid);
                      pg8::EpiQKV E{SS + (size_t)(4 * l + 1) * M, Qb, a.in[7] + j * HD, a.in[8] + j * HD};
                      GEMM_SEAM(false);
                      pg8::gemm_phase<pg8::EpiQKV, true, true>(lds, g, S, E, wv); }
                    SEAM();
                    { OPQ(); REP(4) attn_phase(lds, Qb, Kb, Vb, Ob, G, wv); }
                    { OPQ();
                      pg8::Gemm g{Ob, (const bf16_t*)(ws + WS_WO + (size_t)j * SZ_WDD), D, D, D, 0, 0, 1}; S.init(M, D, G, bid);
                      pg8::EpiRes<0> E{XB, XB, nullptr, SS + (size_t)(4 * l + 2) * M, 1.0f, nullptr, nullptr, nullptr};
                      GEMM_SEAM(false);
                      pg8::gemm_phase<pg8::EpiRes<0>, false, true>(lds, g, S, E, wv); }
                } else {
                    { OPQ();
                      pg8::Gemm g{XB, (const bf16_t*)(ws + WS_WIN + (size_t)j * SZ_WDD), D, D, D, 0, 0, 1}; S.init(M, D, G, bid);
                      pg8::EpiBf16S<true> E{SS + (size_t)(4 * l + 1) * M, Ub, D};
                      GEMM_SEAM(false);
                      pg8::gemm_phase<pg8::EpiBf16S<true>, false, true>(lds, g, S, E, wv); }
                    { OPQ();
                      pg8::Gemm g{PLb, (const bf16_t*)(ws + WS_WGRP + (size_t)j * SZ_WGRP), D, 256, 256, 256, 0, 1}; S.init(M, D, G, bid);
                      pg8::EpiRes<1> E{XB, XB, nullptr, SS + (size_t)(4 * l + 2) * M, 1.0f, a.in[12] + j * D, nullptr, nullptr};
                      GEMM_SEAM(false);
                      { pg8::Unit pu; for (int i = 0; S.next(i, pu); ++i) pool_unit(Ub, PLb, pu.pm, pu.pn, wv); }
                      asm volatile("s_waitcnt vmcnt(0)" ::: "memory"); __syncthreads();
                      pg8::gemm_phase<pg8::EpiRes<1>, false, true>(lds, g, S, E, wv); }
                }
            }
        }
        {
            OPQ();
            if (G != 256) { SEAM();
              pg8::Gemm g{(const bf16_t*)(ws + WS_PB) + (size_t)l * M * PLE, (const bf16_t*)(ws + WS_WPROJ + (size_t)l * SZ_WPROJ), PLE, PLE, PLE, 0, 0, 1}; S.init(M, D, G, bid);
              pg8::EpiBf16S<false> E{nullptr, PE, D};
              pg8::gemm_phase<pg8::EpiBf16S<false>, false, false>(lds, g, S, E, wv); }
            pg8::Gemm g{XB, (const bf16_t*)(ws + WS_WGATE + (size_t)l * SZ_WDD), D, D, D, 0, 0, 1}; S.init(M, D, G, bid);
            GEMM_SEAM(false);
            if (l == DEPTH - 1) { pg8::EpiRes<3> E{XB, nullptr, X, nullptr, 1.0f, nullptr, SS + (size_t)(4 * l + 3) * M, PE}; pg8::gemm_phase<pg8::EpiRes<3>, false, true>(lds, g, S, E, wv); }
            else { pg8::EpiRes<2> E{XB, XBN, nullptr, SS + (size_t)(4 * l + 4) * M, 1.0f, nullptr, SS + (size_t)(4 * l + 3) * M, PE}; pg8::gemm_phase<pg8::EpiRes<2>, false, true>(lds, g, S, E, wv); }
        }
    }
#undef OPQ
#undef SEAM
#undef GEMM_SEAM
}

extern "C" void kernel_launch(void* const* d_in, const int* in_sizes, int n_in, void* d_out, int out_size, void* d_ws, size_t ws_size, hipStream_t stream) {
    static int grid = 0;
    if (grid == 0) {
        if (n_in != 19 || out_size != M * D || ws_size < WS_END) { fprintf(stderr, "kernel_launch: unexpected shapes (n_in %d, out %d, ws %zu, need %zu)\n", n_in, out_size, ws_size, (size_t)WS_END); grid = -1; return; }
        int dev = 0, cus = 0, per_cu = 0;
        hipGetDevice(&dev); hipDeviceGetAttribute(&cus, hipDeviceAttributeMultiprocessorCount, dev);
        if (hipFuncSetAttribute((const void*)fwd_kernel, hipFuncAttributeMaxDynamicSharedMemorySize, LDS_BYTES) != hipSuccess) { fprintf(stderr, "kernel_launch: hipFuncSetAttribute failed\n"); }
        if (hipOccupancyMaxActiveBlocksPerMultiprocessor(&per_cu, (const void*)fwd_kernel, 512, LDS_BYTES) != hipSuccess || per_cu < 1) per_cu = 1;
        (void)hipGetLastError();
        grid = cus * per_cu;
        fprintf(stderr, "kernel_launch: grid %d (cus %d x %d)\n", grid, cus, per_cu);
    }
    if (grid < 0) return;
    Args a{};
    for (int i = 0; i < 19; ++i) a.in[i] = (const float*)d_in[i];
    a.out = (float*)d_out; a.ws = (unsigned char*)d_ws;
    a.ph_lo = 0; a.ph_hi = NPHASE;
    if (hipMemsetAsync((char*)d_ws + WS_BAR, 0, 16384, stream) != hipSuccess) { fprintf(stderr, "kernel_launch: hipMemsetAsync of the barrier words failed\n"); return; }
    void* args[] = {&a};
    hipError_t e = hipLaunchCooperativeKernel((const void*)fwd_kernel, dim3(grid), dim3(512), args, LDS_BYTES, stream);
    if (e != hipSuccess) fprintf(stderr, "cooperative launch failed: %s (grid %d)\n", hipGetErrorString(e), grid);
}
```

```cpp
#include <hip/hip_runtime.h>
#include <hip/hip_cooperative_groups.h>
#include <cstdio>
#include <cstdint>
namespace cg = cooperative_groups;

#define LAS __attribute__((address_space(3)))
typedef unsigned short bf16_t;
typedef short bf16x8 __attribute__((ext_vector_type(8)));
typedef short s16x4 __attribute__((ext_vector_type(4)));
typedef float f32x4 __attribute__((ext_vector_type(4)));
typedef float f32x2 __attribute__((ext_vector_type(2)));
typedef unsigned u32x4 __attribute__((ext_vector_type(4)));
typedef unsigned u32x2 __attribute__((ext_vector_type(2)));

__device__ __forceinline__ int lane_id();
__device__ __forceinline__ int opaque_int(int v);
__device__ __forceinline__ unsigned char* opaque_ptr(unsigned char* p);
__device__ __forceinline__ float shx(float v, int lane, int m) { return __builtin_bit_cast(float, __builtin_amdgcn_ds_bpermute((lane ^ m) << 2, __builtin_bit_cast(int, v))); }
#ifndef DUP_MASK
#define DUP_MASK 0
#endif

constexpr int D = 1024, M = 16384, SEQ = 8192, DEPTH = 4, NH = 16, HD = 64, DFF = 2816, PLE = 256;
constexpr float EPS = 1e-6f;
constexpr int NPHASE = 1 + 8 * DEPTH;

constexpr size_t SZ_SS = (size_t)17 * M * 4;
constexpr size_t SZ_WGU = (size_t)2 * DFF * D * 2, SZ_WDN = (size_t)D * DFF * 2, SZ_WQKV = (size_t)3 * D * D * 2, SZ_WDD = (size_t)D * D * 2, SZ_WGRP = (size_t)4 * 256 * 256 * 2, SZ_WPROJ = (size_t)D * PLE * 2;
constexpr size_t WS_SS = 0;
constexpr size_t WS_BAR = 0x300000;
constexpr size_t WS_WGU = 4u << 20;
constexpr size_t WS_WDN = WS_WGU + 8 * SZ_WGU;
constexpr size_t WS_WQKV = WS_WDN + 8 * SZ_WDN;
constexpr size_t WS_WO = WS_WQKV + 2 * SZ_WQKV;
constexpr size_t WS_WIN = WS_WO + 2 * SZ_WDD;
constexpr size_t WS_WGRP = WS_WIN + 2 * SZ_WDD;
constexpr size_t WS_WGATE = WS_WGRP + 2 * SZ_WGRP;
constexpr size_t WS_WPROJ = WS_WGATE + 4 * SZ_WDD;
constexpr size_t WS_XB = WS_WPROJ + 4 * SZ_WPROJ;
constexpr size_t SZ_MD = (size_t)M * D * 2;
constexpr size_t WS_R1 = WS_XB + SZ_MD;
constexpr size_t WS_PB = WS_R1 + 4 * SZ_MD;
constexpr size_t WS_PE = WS_PB + SZ_MD;
constexpr size_t WS_XB2 = WS_PE + SZ_MD;
constexpr size_t WS_END = WS_XB2 + SZ_MD;
static_assert(SZ_SS <= WS_BAR && WS_BAR + 32768 <= WS_WGU && (size_t)M * DFF * 2 <= 4 * SZ_MD, "ws map");

constexpr int LDS_BYTES = 8 * 16640 + 256;

namespace pg8 {
constexpr int BM = 256, BK = 64, HALF = 128, HTB = HALF * BK * 2, STAGE_BYTES = 8 * HTB, NXCD = 8, WGM = 8;
__host__ __device__ __forceinline__ int lds_byte(int r, int c) { const int st = (r >> 4) * 2 + (c >> 5), rr = r & 15, cc = c & 31, ob = rr * 64 + cc * 2; return st * 1024 + (ob ^ (((ob >> 9) & 1) << 5)); }
__host__ __device__ __forceinline__ void stage_rc(int b, int& R, int& C) { const int st = b / 1024, sb = b % 1024, swz = sb ^ (((sb >> 9) & 1) << 5); R = (st >> 1) * 16 + swz / 64; C = (st & 1) * 32 + (swz % 64) / 2; }
__host__ __device__ __forceinline__ int perm32(int rho) { const int n = rho >> 4, i = rho & 15; return 8 * (i >> 2) + 4 * n + (i & 3); }

struct Unit { int pm, pn; };
struct Gemm { const bf16_t* A; const bf16_t* Bt; int lda, ldb, K; int a_pn_off; int stagger; int epi_rep; int umask = -1; };

struct StaticOrder {
    int nM, nN, nwg, G, c;
    __device__ void init(int M_, int N_, int G_, int c_) { nM = M_ / BM; nN = N_ / BM; nwg = nM * nN; G = G_; c = c_; }
    __device__ bool next(int i, Unit& u) const {
        const int L = i * G + c; if (L >= nwg) return false;
        int wgid = L; { const int q = nwg / NXCD, r = nwg % NXCD, xcd = wgid % NXCD, off = wgid / NXCD; wgid = (xcd < r ? xcd * (q + 1) : r * (q + 1) + (xcd - r) * q) + off; }
        const int nig = WGM * nN, gid = wgid / nig, fm = gid * WGM, gsz = (nM - fm) < WGM ? (nM - fm) : WGM;
        u.pm = fm + ((wgid % nig) % gsz); u.pn = (wgid % nig) / gsz; return true;
    }
};

__device__ __forceinline__ unsigned cvt_pk_bf16(float lo, float hi) { unsigned r; asm volatile("v_cvt_pk_bf16_f32 %0, %1, %2" : "=v"(r) : "v"(lo), "v"(hi)); return r; }
__device__ __forceinline__ u32x4 pack8(const f32x4 a, const f32x4 b) { u32x4 w; w.x = cvt_pk_bf16(a[0], a[1]); w.y = cvt_pk_bf16(a[2], a[3]); w.z = cvt_pk_bf16(b[0], b[1]); w.w = cvt_pk_bf16(b[2], b[3]); return w; }
__device__ __forceinline__ __amdgpu_buffer_rsrc_t wt_rsrc(const void* base, unsigned bytes) { return __builtin_amdgcn_make_buffer_rsrc(const_cast<void*>(base), 0, bytes, 0x00020000); }
__device__ __forceinline__ void st16_wt(__amdgpu_buffer_rsrc_t r, unsigned byte_off, u32x4 v) { __builtin_amdgcn_raw_buffer_store_b128(v, r, byte_off, 0, 16); }
__device__ __forceinline__ float bf_lo(unsigned w) { return __uint_as_float(w << 16); }
__device__ __forceinline__ float bf_hi(unsigned w) { return __uint_as_float(w & 0xffff0000u); }
__device__ __forceinline__ float fast_sigmoid(float v) { return __builtin_amdgcn_rcpf(1.0f + __expf(-v)); }

typedef f32x4 Acc[2][2][4][2];
typedef unsigned ss_t;
constexpr float SS_SCALE = 2048.0f;
__device__ __forceinline__ float ss_rinv_v(ss_t v) { return rsqrtf((float)v * (1.0f / (SS_SCALE * D)) + EPS); }
__device__ __forceinline__ void ss_pre(ss_t (&pv)[8], const ss_t* ss, const Unit& u, int wr, int fr) {
#pragma unroll
    for (int ai = 0; ai < 2; ++ai)
#pragma unroll
        for (int m = 0; m < 4; ++m) pv[ai * 4 + m] = ss[u.pm * BM + wr * 64 + fr + ai * HALF + m * 16];
}
__device__ __forceinline__ void ss_add(ss_t* ss, int row, float s2) { (void)__hip_atomic_fetch_add(ss + row, (unsigned)__float2uint_rn(s2 * SS_SCALE), __ATOMIC_RELAXED, __HIP_MEMORY_SCOPE_AGENT); }

struct EpiGU {
    const ss_t* ss; bf16_t* act;
    __device__ __forceinline__ void pre(ss_t (&pv)[8], const Unit& u, int wr, int fr) const { ss_pre(pv, ss, u, wr, fr); }
    __device__ __forceinline__ void operator()(const Acc& acc, const Unit& u, int wr, int wc, int fr, int fq, const ss_t (&pv)[8]) const {
        const int row0 = u.pm * BM + wr * 64 + fr, col = u.pn * 128 + wc * 32 + 8 * fq;
        const __amdgpu_buffer_rsrc_t ract = wt_rsrc(act, (unsigned)M * DFF * 2u);
#pragma unroll
        for (int ai = 0; ai < 2; ++ai)
#pragma unroll
            for (int m = 0; m < 4; ++m) {
                const int row = row0 + ai * HALF + m * 16;
                const float rinv = ss_rinv_v(pv[ai * 4 + m]);
                f32x4 o[2];
#pragma unroll
                for (int n = 0; n < 2; ++n) {
#pragma unroll
                    for (int h = 0; h < 2; ++h) {
                        const f32x2 g = (f32x2){acc[ai][0][m][n][2 * h], acc[ai][0][m][n][2 * h + 1]} * rinv, up = (f32x2){acc[ai][1][m][n][2 * h], acc[ai][1][m][n][2 * h + 1]} * rinv;
                        const f32x2 t = g * (-1.44269504089f);
                        f32x2 e; e.x = __builtin_amdgcn_exp2f(t.x); e.y = __builtin_amdgcn_exp2f(t.y);
                        const f32x2 d = e + 1.0f;
                        f32x2 r; r.x = __builtin_amdgcn_rcpf(d.x); r.y = __builtin_amdgcn_rcpf(d.y);
                        const f32x2 v = (g * r) * up;
                        o[n][2 * h] = v.x; o[n][2 * h + 1] = v.y;
                    }
                }
                st16_wt(ract, (unsigned)(row * DFF + col) * 2u, pack8(o[0], o[1]));
            }
    }
};
template <int MODE> struct EpiRes {
    const bf16_t* XR; bf16_t* XW; float* OUT; ss_t* ss_next; float alpha; const float* colscale; const ss_t* ss_cur; const bf16_t* pe;
    __device__ __forceinline__ void pre(ss_t (&pv)[8], const Unit& u, int wr, int fr) const { if (MODE >= 2) ss_pre(pv, ss_cur, u, wr, fr); }
    __device__ __forceinline__ void operator()(const Acc& acc, const Unit& u, int wr, int wc, int fr, int fq, const ss_t (&pv)[8]) const {
        const int row0 = u.pm * BM + wr * 64 + fr, colb = u.pn * BM + wc * 32 + 8 * fq;
        f32x4 cs[2][2];
        if (MODE == 1) {
#pragma unroll
            for (int bj = 0; bj < 2; ++bj) { cs[bj][0] = *(const f32x4*)(colscale + colb + bj * HALF); cs[bj][1] = *(const f32x4*)(colscale + colb + bj * HALF + 4); }
        }
#pragma unroll
        for (int ai = 0; ai < 2; ++ai) {
            u32x4 xw[4][2], pw[4][2]; float rinv[4];
#pragma unroll
            for (int m = 0; m < 4; ++m) {
                const int row = row0 + ai * HALF + m * 16;
#pragma unroll
                for (int bj = 0; bj < 2; ++bj) { const size_t off = (size_t)row * D + colb + bj * HALF; xw[m][bj] = *(const u32x4*)(XR + off); if (MODE >= 2) pw[m][bj] = *(const u32x4*)(pe + off); }
                rinv[m] = 1.f; if (MODE >= 2) rinv[m] = ss_rinv_v(pv[ai * 4 + m]);
            }
#pragma unroll
            for (int m = 0; m < 4; ++m) {
                const int row = row0 + ai * HALF + m * 16;
                float s2 = 0.f;
#pragma unroll
                for (int bj = 0; bj < 2; ++bj) {
                    const size_t off = (size_t)row * D + colb + bj * HALF;
                    const u32x4 xq = xw[m][bj];
                    f32x4 x0 = {bf_lo(xq.x), bf_hi(xq.x), bf_lo(xq.y), bf_hi(xq.y)}, x1 = {bf_lo(xq.z), bf_hi(xq.z), bf_lo(xq.w), bf_hi(xq.w)};
                    f32x4 v0 = acc[ai][bj][m][0], v1 = acc[ai][bj][m][1];
                    if (MODE == 0) { v0 = v0 * alpha; v1 = v1 * alpha; }
                    if (MODE == 1) { v0 = v0 * cs[bj][0]; v1 = v1 * cs[bj][1]; }
                    if (MODE >= 2) {
                        const u32x4 pq = pw[m][bj];
                        const f32x4 p0 = {bf_lo(pq.x), bf_hi(pq.x), bf_lo(pq.y), bf_hi(pq.y)}, p1 = {bf_lo(pq.z), bf_hi(pq.z), bf_lo(pq.w), bf_hi(pq.w)};
#pragma unroll
                        for (int e = 0; e < 4; ++e) { v0[e] = fast_sigmoid(v0[e] * rinv[m]) * p0[e]; v1[e] = fast_sigmoid(v1[e] * rinv[m]) * p1[e]; }
                    }
                    x0 = x0 + v0; x1 = x1 + v1;
                    if (MODE == 3) { *(f32x4*)(OUT + off) = x0; *(f32x4*)(OUT + off + 4) = x1; }
                    else *(u32x4*)(XW + off) = pack8(x0, x1);
                    s2 += (x0[0] * x0[0] + x0[1] * x0[1]) + (x0[2] * x0[2] + x0[3] * x0[3]) + (x1[0] * x1[0] + x1[1] * x1[1]) + (x1[2] * x1[2] + x1[3] * x1[3]);
                }
                s2 += shx(s2, fq * 16 + fr, 16); s2 += shx(s2, fq * 16 + fr, 32);
                if (MODE != 3 && fq == 0) ss_add(ss_next, row, s2);
            }
            asm volatile("" ::: "memory");
        }
    }
};
struct EpiNull {
    __device__ __forceinline__ void pre(ss_t (&pv)[8], const Unit& u, int wr, int fr) const {}
    __device__ __forceinline__ void operator()(const Acc& acc, const Unit& u, int wr, int wc, int fr, int fq, const ss_t (&pv)[8]) const {
#pragma unroll
        for (int a = 0; a < 2; ++a)
#pragma unroll
            for (int b = 0; b < 2; ++b)
#pragma unroll
                for (int m = 0; m < 4; ++m)
#pragma unroll
                    for (int n = 0; n < 2; ++n) asm volatile("" :: "v"(acc[a][b][m][n]));
    }
};
struct EpiQKV {
    const ss_t* ss; bf16_t* Q; const float* qg; const float* kg;
    __device__ __forceinline__ void pre(ss_t (&pv)[8], const Unit& u, int wr, int fr) const { ss_pre(pv, ss, u, wr, fr); }
    __device__ __forceinline__ void operator()(const Acc& acc, const Unit& u, int wr, int wc, int fr, int fq, const ss_t (&pv)[8]) const {
        const int which = u.pn >> 2, pnl = u.pn & 3;
        bf16_t* dst = Q + (size_t)which * M * D;
        const int row0 = u.pm * BM + wr * 64 + fr, colb = pnl * 256 + wc * 64 + 8 * fq;
        const float* gp = which == 0 ? qg : kg;
        f32x4 gn[2][2];
#pragma unroll
        for (int bj = 0; bj < 2; ++bj)
#pragma unroll
            for (int n = 0; n < 2; ++n) gn[bj][n] = *(const f32x4*)(gp + 32 * bj + 8 * fq + 4 * n);
        const float qs = which == 0 ? 0.125f : 1.0f;
#pragma unroll
        for (int ai = 0; ai < 2; ++ai)
#pragma unroll
            for (int m = 0; m < 4; ++m) {
                const int row = row0 + ai * HALF + m * 16;
                const float rinv = ss_rinv_v(pv[ai * 4 + m]);
                f32x4 v[2][2]; float s2 = 0.f;
#pragma unroll
                for (int bj = 0; bj < 2; ++bj)
#pragma unroll
                    for (int n = 0; n < 2; ++n) { v[bj][n] = acc[ai][bj][m][n] * rinv; const f32x4 t = v[bj][n]; s2 += (t[0] * t[0] + t[1] * t[1]) + (t[2] * t[2] + t[3] * t[3]); }
                s2 += shx(s2, fq * 16 + fr, 16); s2 += shx(s2, fq * 16 + fr, 32);
                if (which < 2) {
                    const float hr = rsqrtf(s2 * (1.0f / HD) + EPS) * qs;
#pragma unroll
                    for (int bj = 0; bj < 2; ++bj)
#pragma unroll
                        for (int n = 0; n < 2; ++n) v[bj][n] = v[bj][n] * hr * gn[bj][n];
                }
#pragma unroll
                for (int bj = 0; bj < 2; ++bj) *(u32x4*)(dst + (size_t)row * D + colb + 32 * bj) = pack8(v[bj][0], v[bj][1]);
            }
    }
};
template <bool RINV> struct EpiBf16S {
    const ss_t* ss; bf16_t* O; int ldc;
    __device__ __forceinline__ void pre(ss_t (&pv)[8], const Unit& u, int wr, int fr) const { if (RINV) ss_pre(pv, ss, u, wr, fr); }
    __device__ __forceinline__ void operator()(const Acc& acc, const Unit& u, int wr, int wc, int fr, int fq, const ss_t (&pv)[8]) const {
        const int row0 = u.pm * BM + wr * 64 + fr, colb = u.pn * BM + wc * 32 + 8 * fq;
#pragma unroll
        for (int ai = 0; ai < 2; ++ai)
#pragma unroll
            for (int m = 0; m < 4; ++m) {
                const int row = row0 + ai * HALF + m * 16;
                float rinv = 1.f; if (RINV) rinv = ss_rinv_v(pv[ai * 4 + m]);
#pragma unroll
                for (int bj = 0; bj < 2; ++bj) *(u32x4*)(O + (size_t)row * ldc + colb + bj * HALF) = pack8(acc[ai][bj][m][0] * rinv, acc[ai][bj][m][1] * rinv);
            }
    }
};

__device__ __forceinline__ void gemm_prefetch_b(LAS unsigned char* lds, const Gemm g, const StaticOrder& S, int wv) {
    int tid_ = wv * 64 + lane_id(); asm volatile("" : "+v"(tid_));
    const int tid = tid_, wid = __builtin_amdgcn_readfirstlane(tid >> 6);
    Unit cur; if (!S.next(0, cur)) return;
    const size_t hstepB = (size_t)HALF * g.ldb * 2; const char* cB = (const char*)g.Bt + (size_t)cur.pn * 2 * hstepB;
    const unsigned ldsw = (unsigned)wid * 1024u;
#pragma unroll
    for (int i = 0; i < 2; ++i) { int R, C; stage_rc(tid * 16 + i * 8192, R, C); const int Rb = (R & ~31) + perm32(R & 31); const unsigned vo = (unsigned)(Rb * g.ldb + C) * 2u;
#pragma unroll
        for (int b = 0; b < 2; ++b)
#pragma unroll
            for (int h = 0; h < 2; ++h)
                __builtin_amdgcn_global_load_lds((const unsigned*)(cB + (size_t)h * hstepB + (size_t)b * (BK * 2) + vo), (LAS unsigned*)(lds + (4 + b * 2 + h) * HTB + ldsw + i * 8192), 16, 0, 0);
    }
}

template <class Epi, bool ALIGN_EPI, bool BPRE = false>
__device__ __forceinline__ void gemm_phase(LAS unsigned char* lds, const Gemm g, const StaticOrder& S, const Epi& E, int wv) {
    int tid_ = wv * 64 + lane_id(); asm volatile("" : "+v"(tid_));
    const int tid = tid_, wid = __builtin_amdgcn_readfirstlane(tid >> 6), lane = tid & 63, wr = wid >> 2, wc = wid & 3, fr = lane & 15, fq = lane >> 4;
    const int K = g.K, nt = K / BK;
    unsigned voffA[2], voffB[2];
#pragma unroll
    for (int i = 0; i < 2; ++i) { int R, C; stage_rc(tid * 16 + i * 8192, R, C); const int Rb = (R & ~31) + perm32(R & 31);
        voffA[i] = (unsigned)(R * g.lda + C) * 2u; voffB[i] = (unsigned)(Rb * g.ldb + C) * 2u; }
    const size_t kstep = (size_t)(BK * 2);
    const size_t hstepA = (size_t)HALF * g.lda * 2, hstepB = (size_t)HALF * g.ldb * 2;
    const size_t tstepA = 2 * hstepA, tstepB = 2 * hstepB;
    const unsigned ldsw = (unsigned)wid * 1024u;
    const int aoff = lds_byte(wr * 64 + fr, fq * 8), boff = lds_byte(wc * 32 + fr, fq * 8);
#define PG8_SA(b, h) (((b) * 2 + (h)) * HTB)
#define PG8_SB(b, h) ((4 + (b) * 2 + (h)) * HTB)
#define PG8_STAGE(bufoff, gbase, voff) do { _Pragma("unroll") for (int _i = 0; _i < 2; ++_i) \
        __builtin_amdgcn_global_load_lds((const unsigned*)((const char*)(gbase) + (voff)[_i]), (LAS unsigned*)(lds + (bufoff) + ldsw + _i * 8192), 16, 0, 0); } while (0)
#define PG8_LDA(dst, b, h) do { _Pragma("unroll") for (int m = 0; m < 4; ++m) _Pragma("unroll") for (int k = 0; k < 2; ++k) dst[m][k] = *(const LAS bf16x8*)(lds + PG8_SA(b, h) + aoff + m * 2048 + k * 1024); } while (0)
#define PG8_LDB(dst, b, h) do { _Pragma("unroll") for (int n = 0; n < 2; ++n) _Pragma("unroll") for (int k = 0; k < 2; ++k) dst[n][k] = *(const LAS bf16x8*)(lds + PG8_SB(b, h) + boff + n * 2048 + k * 1024); } while (0)
#define PG8_MMA(ai, bj, At, Bt) do { __builtin_amdgcn_s_setprio(1); _Pragma("unroll") for (int m = 0; m < 4; ++m) _Pragma("unroll") for (int n = 0; n < 2; ++n) _Pragma("unroll") for (int k = 0; k < 2; ++k) \
        acc[ai][bj][m][n] = __builtin_amdgcn_mfma_f32_16x16x32_bf16(Bt[n][k], At[m][k], acc[ai][bj][m][n], 0, 0, 0); __builtin_amdgcn_s_setprio(0); } while (0)
#define PG8_WAIT_V(n) asm volatile("s_waitcnt vmcnt(" #n ")" ::: "memory")
#define PG8_WAIT_L(n) asm volatile("s_waitcnt lgkmcnt(" #n ")" ::: "memory")
#define PG8_BAR __builtin_amdgcn_s_barrier()
#define PG8_SCHED __builtin_amdgcn_sched_barrier(0)
    Unit cur, nxt; int ui = 0;
    if (!S.next(0, cur)) return;
    if (g.stagger > 0 && (S.nwg - S.c + S.G - 1) / S.G < (S.nwg + S.G - 1) / S.G) { const unsigned long long t0 = __builtin_amdgcn_s_memrealtime(); while (__builtin_amdgcn_s_memrealtime() - t0 < (unsigned long long)g.stagger) __builtin_amdgcn_s_sleep(16); }
    Acc acc;
#pragma unroll
    for (int a = 0; a < 2; ++a)
#pragma unroll
        for (int b = 0; b < 2; ++b)
#pragma unroll
            for (int m = 0; m < 4; ++m)
#pragma unroll
                for (int n = 0; n < 2; ++n) acc[a][b][m][n] = (f32x4){0.f, 0.f, 0.f, 0.f};
    bf16x8 At[4][2], B0[2][2], B1[2][2];
    ss_t pv[8];
#pragma unroll
    for (int i = 0; i < 8; ++i) pv[i] = 0;
    const char* cA = (const char*)g.A + (size_t)(cur.pm & g.umask) * tstepA + (size_t)(cur.pn & g.umask) * g.a_pn_off * 2; const char* cB = (const char*)g.Bt + (size_t)(cur.pn & g.umask) * tstepB;
    if constexpr (BPRE) {
        PG8_STAGE(PG8_SA(0, 0), cA, voffA); PG8_STAGE(PG8_SA(0, 1), cA + hstepA, voffA);
        if (wr == 1) PG8_BAR;
        PG8_WAIT_V(2); PG8_BAR;
        PG8_STAGE(PG8_SA(1, 0), cA + kstep, voffA);
        PG8_WAIT_V(2); PG8_BAR;
    } else {
    PG8_STAGE(PG8_SB(0, 0), cB, voffB); PG8_STAGE(PG8_SB(0, 1), cB + hstepB, voffB); PG8_STAGE(PG8_SA(0, 0), cA, voffA); PG8_STAGE(PG8_SA(0, 1), cA + hstepA, voffA);
    if (wr == 1) PG8_BAR;
    PG8_WAIT_V(2); PG8_BAR;
    PG8_STAGE(PG8_SB(1, 0), cB + kstep, voffB); PG8_STAGE(PG8_SA(1, 0), cA + kstep, voffA); PG8_STAGE(PG8_SB(1, 1), cB + hstepB + kstep, voffB);
    PG8_WAIT_V(6); PG8_BAR;
    }
    for (;;) {
        const bool has_next = S.next(ui + 1, nxt);
        const char* nA = has_next ? (const char*)g.A + (size_t)(nxt.pm & g.umask) * tstepA + (size_t)(nxt.pn & g.umask) * g.a_pn_off * 2 : cA; const char* nB = has_next ? (const char*)g.Bt + (size_t)(nxt.pn & g.umask) * tstepB : cB;
        for (int t = 0; t < nt; t += 2) {
            const bool last = (t == nt - 2);
            if (last) E.pre(pv, cur, wr, lane_id() & 15);
            const char* a1 = cA + (size_t)(t + 1) * kstep;
            const char* a2 = last ? nA : cA + (size_t)(t + 2) * kstep; const char* b2 = last ? nB : cB + (size_t)(t + 2) * kstep;
            const char* a3 = a2 + kstep; const char* b3 = b2 + kstep;
            PG8_LDB(B0, 0, 0); PG8_LDB(B1, 0, 1); PG8_SCHED; PG8_LDA(At, 0, 0); PG8_STAGE(PG8_SA(1, 1), a1 + hstepA, voffA);
            PG8_WAIT_V(8); PG8_WAIT_L(0); PG8_BAR; PG8_MMA(0, 0, At, B0); PG8_MMA(0, 1, At, B1); PG8_BAR; PG8_SCHED;
            PG8_LDA(At, 0, 1); PG8_STAGE(PG8_SB(0, 0), b2, voffB); PG8_STAGE(PG8_SB(0, 1), b2 + hstepB, voffB); PG8_STAGE(PG8_SA(0, 0), a2, voffA);
            PG8_WAIT_V(8); PG8_WAIT_L(0); PG8_BAR; PG8_MMA(1, 0, At, B0); PG8_MMA(1, 1, At, B1); PG8_BAR; PG8_SCHED;
            PG8_LDB(B0, 1, 0); PG8_LDB(B1, 1, 1); PG8_SCHED; PG8_LDA(At, 1, 0); PG8_STAGE(PG8_SA(0, 1), a2 + hstepA, voffA);
            PG8_WAIT_V(8); PG8_WAIT_L(0); PG8_BAR; PG8_MMA(0, 0, At, B0); PG8_MMA(0, 1, At, B1); PG8_BAR; PG8_SCHED;
            PG8_LDA(At, 1, 1); PG8_STAGE(PG8_SB(1, 0), b3, voffB); PG8_STAGE(PG8_SB(1, 1), b3 + hstepB, voffB); PG8_STAGE(PG8_SA(1, 0), a3, voffA);
            PG8_WAIT_V(8); PG8_WAIT_L(0); PG8_BAR; PG8_MMA(1, 0, At, B0); PG8_MMA(1, 1, At, B1); PG8_BAR; PG8_SCHED;
        }
        if constexpr (ALIGN_EPI) { if (wr == 0) PG8_BAR; }
        _Pragma("unroll 1") for (int er_ = 0; er_ < g.epi_rep; ++er_) { const int l2 = lane_id(); E(acc, cur, wr, wc, l2 & 15, l2 >> 4, pv); }
        if (!has_next) break;
#pragma unroll
        for (int a = 0; a < 2; ++a)
#pragma unroll
            for (int b = 0; b < 2; ++b)
#pragma unroll
                for (int m = 0; m < 4; ++m)
#pragma unroll
                    for (int n = 0; n < 2; ++n) acc[a][b][m][n] = (f32x4){0.f, 0.f, 0.f, 0.f};
        cur = nxt; cA = nA; cB = nB; ++ui;
        if constexpr (ALIGN_EPI) { if (wr == 1) PG8_BAR; }
    }
    PG8_WAIT_V(0);
    if constexpr (!ALIGN_EPI) { if (wr == 0) PG8_BAR; }
    PG8_BAR;
#undef PG8_SA
#undef PG8_SB
#undef PG8_STAGE
#undef PG8_LDA
#undef PG8_LDB
#undef PG8_MMA
#undef PG8_WAIT_V
#undef PG8_WAIT_L
#undef PG8_BAR
#undef PG8_SCHED
}
}

__device__ __forceinline__ unsigned f2bf(float f) { unsigned u = __builtin_bit_cast(unsigned, f); return (u + 0x7fffu + ((u >> 16) & 1u)) >> 16; }
__device__ __forceinline__ unsigned pk2(float lo, float hi) { return f2bf(lo) | (f2bf(hi) << 16); }
__device__ __forceinline__ float wave_sum(float v, int lane) {
#pragma unroll
    for (int o = 1; o < 64; o <<= 1) v += shx(v, lane, o);
    return v;
}
template <int MAP> __device__ __forceinline__ int map_row(int n0) {
    if (MAP == 1) { const int up = n0 >= DFF ? 1 : 0, j = n0 - up * DFF; return 256 * (j >> 7) + 128 * up + (j & 127); }
    if (MAP == 2) { const int pn = n0 >> 8, r = n0 & 255, wc = r >> 6, bj = (r >> 5) & 1; return 256 * pn + 128 * bj + 32 * wc; }
    return n0;
}
template <int MAP> __device__ __forceinline__ void conv_item(const float* W, int K, int N, bf16_t* WT, const float* gain, LAS float* scr, int item, int lane) {
    const int nblk = N / 64, kb = item / nblk, nb = item % nblk, k0 = 64 * kb, n0 = 64 * nb;
    const int c4 = lane & 15, kr = lane >> 4;
    f32x4 v[16];
#pragma unroll
    for (int i = 0; i < 16; ++i) v[i] = *(const f32x4*)(W + (size_t)(k0 + 4 * i + kr) * N + n0 + 4 * c4);
    if (gain) {
#pragma unroll
        for (int i = 0; i < 16; ++i) v[i] = v[i] * gain[k0 + 4 * i + kr];
    }
#pragma unroll
    for (int i = 0; i < 16; ++i) { const int kk = 4 * i + kr; LAS float* t = scr + (4 * c4) * 65 + kk; t[0] = v[i][0]; t[65] = v[i][1]; t[130] = v[i][2]; t[195] = v[i][3]; }
    asm volatile("s_waitcnt lgkmcnt(0)" ::: "memory");
    const int c = lane & 7, nr = lane >> 3;
#pragma unroll
    for (int j = 0; j < 8; ++j) { const int n = nr + 8 * j; const LAS float* t = scr + n * 65 + 8 * c;
        u32x4 o; o.x = pk2(t[0], t[1]); o.y = pk2(t[2], t[3]); o.z = pk2(t[4], t[5]); o.w = pk2(t[6], t[7]);
        const int r = map_row<MAP>(n0 + (n & 32)) + (n & 31);
        *(u32x4*)(WT + (size_t)r * K + k0 + 8 * c) = o; }
    asm volatile("s_waitcnt lgkmcnt(0)" ::: "memory");
}

__device__ __forceinline__ int lane_id() { int l; asm volatile("v_mbcnt_lo_u32_b32 %0, -1, 0\n\tv_mbcnt_hi_u32_b32 %0, -1, %0" : "=v"(l)); return l; }
__device__ __forceinline__ int opaque_int(int v) { asm volatile("" : "+s"(v)); return v; }
__device__ __forceinline__ unsigned char* opaque_ptr(unsigned char* p) { unsigned z = 0; asm volatile("" : "+s"(z)); return p + z; }
struct Args { const float* in[19]; float* out; unsigned char* ws; int ph_lo, ph_hi; };

template <int MAP> __device__ __forceinline__ void conv_mat(const float* W, int K, int N, bf16_t* WT, const float* gain, LAS float* scr, int gw, int NGW, int& off, int lane) {
    const int nitems = (K / 64) * (N / 64);
    int start = gw - off; if (start < 0) start += NGW;
    for (int it = start; it < nitems; it += NGW) conv_item<MAP>(W, K, N, WT, gain, scr, it, lane);
    off = (off + nitems) % NGW;
}

__device__ __forceinline__ void prologue(const Args& a, LAS unsigned char* lds, int G) {
    const int tid = threadIdx.x, lane = tid & 63, wave = tid >> 6;
    const int gw = blockIdx.x * 8 + wave, NGW = G * 8;
    unsigned char* ws = a.ws;
    { unsigned* ss = (unsigned*)(ws + WS_SS) + M; const int n4 = 16 * M / 4;
      for (int i = blockIdx.x * 512 + tid; i < n4; i += G * 512) ((f32x4*)ss)[i] = (f32x4){0.f, 0.f, 0.f, 0.f}; }
    { unsigned* ss0 = (unsigned*)(ws + WS_SS); bf16_t* xb = (bf16_t*)(ws + WS_XB);
      for (int m0 = gw; m0 < M; m0 += 4 * NGW) {
          f32x4 v[4][4];
#pragma unroll
          for (int r = 0; r < 4; ++r) { const int m = m0 + r * NGW; if (m < M) { const f32x4* xr = (const f32x4*)(a.in[0] + (size_t)m * D) + lane;
#pragma unroll
              for (int j = 0; j < 4; ++j) v[r][j] = xr[64 * j]; } }
#pragma unroll
          for (int r = 0; r < 4; ++r) { const int m = m0 + r * NGW; if (m < M) { u32x2* brow = (u32x2*)(xb + (size_t)m * D) + lane; float s = 0.f;
#pragma unroll
              for (int j = 0; j < 4; ++j) { const f32x4 q = v[r][j]; u32x2 w; w.x = pk2(q[0], q[1]); w.y = pk2(q[2], q[3]); brow[64 * j] = w; s += (q[0] * q[0] + q[1] * q[1]) + (q[2] * q[2] + q[3] * q[3]); }
              s = wave_sum(s, lane); if (lane == 0) ss0[m] = __float2uint_rn(s * pg8::SS_SCALE); } }
      } }
    const bool defer = G == 256;
    if (!defer) { const f32x4* p4 = (const f32x4*)a.in[1]; u32x4* pb = (u32x4*)(ws + WS_PB); const int n8 = DEPTH * M * PLE / 8;
      for (int i = blockIdx.x * 512 + tid; i < n8; i += G * 512) { const f32x4 v0 = p4[2 * i], v1 = p4[2 * i + 1]; u32x4 w; w.x = pk2(v0[0], v0[1]); w.y = pk2(v0[2], v0[3]); w.z = pk2(v1[0], v1[1]); w.w = pk2(v1[2], v1[3]); pb[i] = w; } }
    LAS float* scr = (LAS float*)(lds + wave * 16640);
    int off = 0;
#pragma unroll 1
    for (int l = 0; l < DEPTH; ++l) {
        conv_mat<1>(a.in[3] + (size_t)l * D * 2 * DFF, D, 2 * DFF, (bf16_t*)(ws + WS_WGU + (size_t)(2 * l) * SZ_WGU), a.in[2] + l * D, scr, gw, NGW, off, lane);
        conv_mat<1>(a.in[14] + (size_t)l * D * 2 * DFF, D, 2 * DFF, (bf16_t*)(ws + WS_WGU + (size_t)(2 * l + 1) * SZ_WGU), a.in[13] + l * D, scr, gw, NGW, off, lane);
        conv_mat<0>(a.in[4] + (size_t)l * DFF * D, DFF, D, (bf16_t*)(ws + WS_WDN + (size_t)(2 * l) * SZ_WDN), nullptr, scr, gw, NGW, off, lane);
        conv_mat<0>(a.in[15] + (size_t)l * DFF * D, DFF, D, (bf16_t*)(ws + WS_WDN + (size_t)(2 * l + 1) * SZ_WDN), nullptr, scr, gw, NGW, off, lane);
        conv_mat<0>(a.in[17] + (size_t)l * D * D, D, D, (bf16_t*)(ws + WS_WGATE + (size_t)l * SZ_WDD), a.in[16] + l * D, scr, gw, NGW, off, lane);
        conv_mat<0>(a.in[18] + (size_t)l * PLE * D, PLE, D, (bf16_t*)(ws + WS_WPROJ + (size_t)l * SZ_WPROJ), nullptr, scr, gw, NGW, off, lane);
    }
#pragma unroll 1
    for (int j = 0; j < 2; ++j) {
        conv_mat<2>(a.in[6] + (size_t)j * D * 3 * D, D, 3 * D, (bf16_t*)(ws + WS_WQKV + (size_t)j * SZ_WQKV), a.in[5] + (2 * j) * D, scr, gw, NGW, off, lane);
        conv_mat<0>(a.in[9] + (size_t)j * D * D, D, D, (bf16_t*)(ws + WS_WO + (size_t)j * SZ_WDD), nullptr, scr, gw, NGW, off, lane);
        conv_mat<0>(a.in[10] + (size_t)j * D * D, D, D, (bf16_t*)(ws + WS_WIN + (size_t)j * SZ_WDD), a.in[5] + (2 * j + 1) * D, scr, gw, NGW, off, lane);
#pragma unroll 1
        for (int g = 0; g < 4; ++g)
            conv_mat<0>(a.in[11] + (size_t)(j * 4 + g) * 256 * 256, 256, 256, (bf16_t*)(ws + WS_WGRP + (size_t)j * SZ_WGRP + (size_t)g * 256 * 256 * 2), nullptr, scr, gw, NGW, off, lane);
    }
}

__device__ __forceinline__ void unpack8(const u32x4 w, float* f) {
    f[0] = pg8::bf_lo(w.x); f[1] = pg8::bf_hi(w.x); f[2] = pg8::bf_lo(w.y); f[3] = pg8::bf_hi(w.y); f[4] = pg8::bf_lo(w.z); f[5] = pg8::bf_hi(w.z); f[6] = pg8::bf_lo(w.w); f[7] = pg8::bf_hi(w.w);
}
template <int W> __device__ __forceinline__ void pool_strip(const bf16_t* up, bf16_t* pp, int t0) {
    constexpr int NR = 15 + W;
    u32x4 raw[NR];
#pragma unroll
    for (int j = 0; j < NR; ++j) { const int dj = j - (W - 1); raw[j] = (t0 + dj >= 0) ? *(const u32x4*)(up + (ptrdiff_t)dj * D) : (u32x4){0u, 0u, 0u, 0u}; }
    float S[8];
#pragma unroll
    for (int e = 0; e < 8; ++e) S[e] = 0.f;
#pragma unroll
    for (int j = 0; j < W - 1; ++j) { float f[8]; unpack8(raw[j], f);
#pragma unroll
        for (int e = 0; e < 8; ++e) S[e] += f[e]; }
#pragma unroll
    for (int r = 0; r < 16; ++r) {
        float cur[8]; unpack8(raw[r + W - 1], cur);
        const int t = t0 + r; const float ic = 1.0f / (float)(t + 1 < W ? t + 1 : W); float o[8];
#pragma unroll
        for (int e = 0; e < 8; ++e) { S[e] += cur[e]; o[e] = S[e] * ic - cur[e]; }
        u32x4 ow; ow.x = pk2(o[0], o[1]); ow.y = pk2(o[2], o[3]); ow.z = pk2(o[4], o[5]); ow.w = pk2(o[6], o[7]);
        *(u32x4*)(pp + (ptrdiff_t)r * D) = ow;
        float old[8]; unpack8(raw[r], old);
#pragma unroll
        for (int e = 0; e < 8; ++e) S[e] -= old[e];
    }
}
__device__ __forceinline__ void pool_phase(const bf16_t* U, bf16_t* P, int G, int wv) {
    int lane_ = lane_id(); asm volatile("" : "+v"(lane_));
    const int lane = lane_;
    for (int it = blockIdx.x * 8 + wv; it < (M / 32) * 4; it += G * 8) {
        const int grp = it & 3, sp = it >> 2, strip = 2 * sp + (lane >> 5), chunk = grp * 32 + (lane & 31), row0 = strip * 16, t0 = row0 & (SEQ - 1);
        const bf16_t* up = U + (size_t)row0 * D + chunk * 8; bf16_t* pp = P + (size_t)row0 * D + chunk * 8;
        if (grp == 0) pool_strip<2>(up, pp, t0); else if (grp == 1) pool_strip<4>(up, pp, t0); else if (grp == 2) pool_strip<8>(up, pp, t0); else pool_strip<16>(up, pp, t0);
    }
}

__device__ __forceinline__ void pool_unit(const bf16_t* U, bf16_t* P, int pm, int pn, int wv) {
    int lane_ = lane_id(); asm volatile("" : "+v"(lane_));
    const int tid = wv * 64 + lane_, strip = pm * 16 + (tid >> 5), chunk = pn * 32 + (tid & 31), row0 = strip * 16, t0 = row0 & (SEQ - 1);
    const bf16_t* up = U + (size_t)row0 * D + chunk * 8; bf16_t* pp = P + (size_t)row0 * D + chunk * 8;
    if (pn == 0) pool_strip<2>(up, pp, t0); else if (pn == 1) pool_strip<4>(up, pp, t0); else if (pn == 2) pool_strip<8>(up, pp, t0); else pool_strip<16>(up, pp, t0);
}

__device__ __forceinline__ void attn_phase(LAS unsigned char* lds, const bf16_t* Q, const bf16_t* Kg, const bf16_t* Vg, bf16_t* O, int G, int wv) {
    LAS bf16_t* Ks0 = (LAS bf16_t*)lds;
    LAS bf16_t* Vt0 = (LAS bf16_t*)(lds + 2 * 9216);
    LAS unsigned* flags0 = (LAS unsigned*)(lds + 2 * 9216 + 2 * 8704);
    int par = 0;
    int tid_ = wv * 64 + lane_id(); asm volatile("" : "+v"(tid_));
    const int tid = tid_, wid = tid >> 6, lane = tid & 63, l16 = lane & 15, g = lane >> 4;
    constexpr int NU = 2 * NH * (SEQ / 128);
    const int key = tid >> 3, dc = tid & 7;
    bf16x8 qf[2]; u32x4 kv, vv;
    if ((int)blockIdx.x < NU) { const int unit = blockIdx.x, qblk = unit & 63, bh = unit >> 6, b = bh >> 4, h = bh & 15; const size_t rowbase = (size_t)b * SEQ;
        const bf16_t* qp = Q + (rowbase + qblk * 128 + wid * 16 + l16) * D + h * HD + 8 * g; qf[0] = *(const bf16x8*)qp; qf[1] = *(const bf16x8*)(qp + 32);
        const size_t src = (rowbase + key) * D + h * HD + 8 * dc + (size_t)(2 * qblk + 1) * 64 * D; kv = *(const u32x4*)(Kg + src); vv = *(const u32x4*)(Vg + src); }
    for (int unit = blockIdx.x; unit < NU; unit += G) {
        const int qblk = unit & 63, bh = unit >> 6, b = bh >> 4, h = bh & 15;
        const size_t rowbase = (size_t)b * SEQ; const int t0 = qblk * 128 + wid * 16, tq = t0 + l16;
        const bool has_next = unit + G < NU;
        bf16x8 qn[2]; u32x4 kvn, vvn;
        if (has_next) { const int un = unit + G, qb2 = un & 63, bh2 = un >> 6, b2 = bh2 >> 4, h2 = bh2 & 15; const size_t rb2 = (size_t)b2 * SEQ;
            const bf16_t* qp = Q + (rb2 + qb2 * 128 + wid * 16 + l16) * D + h2 * HD + 8 * g; qn[0] = *(const bf16x8*)qp; qn[1] = *(const bf16x8*)(qp + 32);
            const size_t src = (rb2 + key) * D + h2 * HD + 8 * dc + (size_t)(2 * qb2 + 1) * 64 * D; kvn = *(const u32x4*)(Kg + src); vvn = *(const u32x4*)(Vg + src); }
        f32x4 o[4];
#pragma unroll
        for (int i = 0; i < 4; ++i) o[i] = (f32x4){0.f, 0.f, 0.f, 0.f};
        float carry = 1.f; unsigned wave_done = 0u;
        const size_t srcb = (rowbase + key) * D + h * HD + 8 * dc;
        for (int kt = 2 * qblk + 1; kt >= 0; --kt) {
            LAS bf16_t* Ks = Ks0 + par * (64 * 72); LAS bf16_t* Vt = Vt0 + par * (64 * 68); LAS unsigned* flags = flags0 + par * 8; par ^= 1;
            if (lane == 0) flags[wid] = wave_done;
            { *(LAS u32x4*)(Ks + key * 72 + 8 * dc) = kv;
              LAS bf16_t* vd = Vt + (8 * dc) * 68 + key;
              vd[0 * 68] = (bf16_t)(vv.x & 0xffffu); vd[1 * 68] = (bf16_t)(vv.x >> 16); vd[2 * 68] = (bf16_t)(vv.y & 0xffffu); vd[3 * 68] = (bf16_t)(vv.y >> 16);
              vd[4 * 68] = (bf16_t)(vv.z & 0xffffu); vd[5 * 68] = (bf16_t)(vv.z >> 16); vd[6 * 68] = (bf16_t)(vv.w & 0xffffu); vd[7 * 68] = (bf16_t)(vv.w >> 16); }
            __syncthreads();
            unsigned all = 1u;
#pragma unroll
            for (int i = 0; i < 8; ++i) all &= flags[i];
            if (all) break;
            if (kt > 0) { const size_t src = srcb + (size_t)(kt - 1) * 64 * D; kv = *(const u32x4*)(Kg + src); vv = *(const u32x4*)(Vg + src); }
            if (!wave_done && kt * 64 <= t0 + 14) {
                f32x4 z[4];
#pragma unroll
                for (int bb = 0; bb < 4; ++bb) { z[bb] = (f32x4){0.f, 0.f, 0.f, 0.f};
#pragma unroll
                    for (int ks = 0; ks < 2; ++ks) { const bf16x8 ka = *(const LAS bf16x8*)(Ks + (16 * bb + l16) * 72 + 32 * ks + 8 * g); z[bb] = __builtin_amdgcn_mfma_f32_16x16x32_bf16(ka, qf[ks], z[bb], 0, 0, 0); } }
                f32x2 st[4][2], be[4][2]; float tot[4], Ex[4];
                const bool diag = kt * 64 + 63 >= t0;
#pragma unroll
                for (int bb = 0; bb < 4; ++bb) {
#pragma unroll
                    for (int h = 0; h < 2; ++h) {
                        const f32x2 t = (f32x2){z[bb][2 * h], z[bb][2 * h + 1]} * 1.44269504089f;
                        f32x2 e; e.x = __builtin_amdgcn_exp2f(t.x); e.y = __builtin_amdgcn_exp2f(t.y);
                        const f32x2 d = e + 1.0f;
                        f32x2 r; r.x = __builtin_amdgcn_rcpf(d.x); r.y = __builtin_amdgcn_rcpf(d.y);
                        f32x2 b_ = 1.0f - r;
                        if (diag) { const int s = kt * 64 + 16 * bb + 4 * g + 2 * h;
                            if (!(s < tq)) { r.x = 1.f; b_.x = 0.f; }
                            if (!(s + 1 < tq)) { r.y = 1.f; b_.y = 0.f; } }
                        st[bb][h] = r; be[bb][h] = b_;
                    }
                    const f32x2 pp = st[bb][0] * st[bb][1]; const float T = pp.x * pp.y;
                    const float a_ = shx(T, lane, 16), b2 = T * a_, c_ = shx(b2, lane, 32);
                    tot[bb] = b2 * c_; Ex[bb] = ((g & 1) == 0 ? a_ : 1.f) * ((g & 2) == 0 ? c_ : 1.f);
                }
                float wv[4][4]; float right = carry;
#pragma unroll
                for (int bb = 3; bb >= 0; --bb) {
                    const float base = right * Ex[bb];
                    const float p2 = st[bb][1].y, p1 = p2 * st[bb][1].x, p0 = p1 * st[bb][0].y;
                    const f32x2 w1 = (be[bb][1] * (f32x2){p2, 1.f}) * base, w0 = (be[bb][0] * (f32x2){p0, p1}) * base;
                    wv[bb][0] = w0.x; wv[bb][1] = w0.y; wv[bb][2] = w1.x; wv[bb][3] = w1.y;
                    right *= tot[bb];
                }
                carry = right;
#pragma unroll
                for (int c = 0; c < 2; ++c) {
                    u32x4 pw; pw.x = pg8::cvt_pk_bf16(wv[2 * c][0], wv[2 * c][1]); pw.y = pg8::cvt_pk_bf16(wv[2 * c][2], wv[2 * c][3]);
                    pw.z = pg8::cvt_pk_bf16(wv[2 * c + 1][0], wv[2 * c + 1][1]); pw.w = pg8::cvt_pk_bf16(wv[2 * c + 1][2], wv[2 * c + 1][3]);
                    const bf16x8 pbf = __builtin_bit_cast(bf16x8, pw);
#pragma unroll
                    for (int db = 0; db < 4; ++db) {
                        const LAS bf16_t* vp = Vt + (16 * db + l16) * 68 + 32 * c + 4 * g;
                        const u32x2 v0 = *(const LAS u32x2*)vp, v1 = *(const LAS u32x2*)(vp + 16);
                        u32x4 va; va.x = v0.x; va.y = v0.y; va.z = v1.x; va.w = v1.y;
                        o[db] = __builtin_amdgcn_mfma_f32_16x16x32_bf16(__builtin_bit_cast(bf16x8, va), pbf, o[db], 0, 0, 0);
                    }
                }
                wave_done = (__builtin_amdgcn_ballot_w64(carry < 1e-37f) == ~0ull) ? 1u : 0u;
            }
        }
        { bf16_t* op = O + (rowbase + tq) * D + h * HD + 4 * g;
#pragma unroll
          for (int db = 0; db < 4; ++db) { u32x2 w; w.x = pg8::cvt_pk_bf16(o[db][0], o[db][1]); w.y = pg8::cvt_pk_bf16(o[db][2], o[db][3]); *(u32x2*)(op + 16 * db) = w; } }
        if (has_next) { qf[0] = qn[0]; qf[1] = qn[1]; kv = kvn; vv = vvn; }
    }
    __syncthreads();
}

#define XB_TMO      128
#define XB_XCNT(j)  (256  + 64 * (j))
#define XB_XSUB(j)  (1280 + 64 * (j))
#define XB_XGEN(j)  (2304 + 64 * (j))
#define XB_TOP      3328
#define XB_TOPGEN   3392
#define XCD_BAR_WORDS 3456
#define XB_SPIN_CAP (1u << 18)
__device__ __forceinline__ unsigned xb_ld(unsigned* p)              { return __hip_atomic_load(p, __ATOMIC_RELAXED, __HIP_MEMORY_SCOPE_AGENT); }
__device__ __forceinline__ unsigned xb_add(unsigned* p, unsigned v) { return __hip_atomic_fetch_add(p, v, __ATOMIC_RELAXED, __HIP_MEMORY_SCOPE_AGENT); }
__device__ __forceinline__ unsigned xb_xcc_id() { return (unsigned)__builtin_amdgcn_s_getreg((3 << 11) | 20) & 0xFu; }
#define XB_SPIN(cond, bar) do { unsigned _sp = 0; while (cond) { __builtin_amdgcn_s_sleep(1); \
    if ((++_sp & 255u) == 0u) { if (xb_ld(&(bar)[XB_TMO])) break; if (_sp > XB_SPIN_CAP) { atomicAdd(&(bar)[XB_TMO], 1u); break; } } } } while (0)
struct XcdBarrier { unsigned* bar; unsigned x; volatile LAS unsigned* st; };
__device__ __forceinline__ XcdBarrier xcd_barrier_post(unsigned* bar, volatile LAS unsigned* st) {
    XcdBarrier b; b.bar = bar; b.x = xb_xcc_id(); b.st = st;
    if (threadIdx.x == 0) (void)xb_add(&bar[XB_XCNT(b.x)], 1u);
    return b;
}
__device__ __forceinline__ void xcd_barrier_complete(unsigned* bar, unsigned x, unsigned& nloc, unsigned& nx) {
    const unsigned G = gridDim.x * gridDim.y * gridDim.z;
    unsigned sum, cnt, mine, sp = 0u;
    for (;;) {
        sum = 0u; cnt = 0u; mine = 0u;
#pragma unroll
        for (unsigned j = 0; j < 16; ++j) { const unsigned c = xb_ld(&bar[XB_XCNT(j)]); sum += c; cnt += (c > 0u) ? 1u : 0u; mine = (j == x) ? c : mine; }
        if (sum == G) break;
        __builtin_amdgcn_s_sleep(1);
        if ((++sp & 255u) == 0u) { if (xb_ld(&bar[XB_TMO])) break; if (sp > XB_SPIN_CAP) { atomicAdd(&bar[XB_TMO], 1u); break; } }
    }
    nloc = mine > 0u ? mine : 1u; nx = cnt > 0u ? cnt : 1u;
}
__device__ __forceinline__ void xcd_barrier(const XcdBarrier& b, int wv) {
    asm volatile("s_waitcnt vmcnt(0)" ::: "memory");
    __syncthreads();
    if (opaque_int(wv) == 0) { if (lane_id() == 0) {
        unsigned* bar = (unsigned*)opaque_ptr((unsigned char*)b.bar);
        __builtin_amdgcn_s_waitcnt(0);
        unsigned nloc = b.st[0], nx = b.st[1];
        if (nloc == 0u) { xcd_barrier_complete(bar, b.x, nloc, nx); b.st[0] = nloc; b.st[1] = nx; }
        const unsigned old = xb_add(&bar[XB_XSUB(b.x)], 1u);
        const unsigned gen = old / nloc;
        if (old + 1u == (gen + 1u) * nloc) {
            __builtin_amdgcn_fence(__ATOMIC_RELEASE, "agent");
            asm volatile("s_waitcnt vmcnt(0)" ::: "memory");
            const unsigned og = xb_add(&bar[XB_TOP], 1u);
            const unsigned tg = og / nx;
            if (og + 1u == (tg + 1u) * nx) xb_add(&bar[XB_TOPGEN], 1u);
            else XB_SPIN(xb_ld(&bar[XB_TOPGEN]) == tg, bar);
            __builtin_amdgcn_fence(__ATOMIC_ACQUIRE, "agent");
            xb_add(&bar[XB_XGEN(b.x)], 1u);
            asm volatile("s_waitcnt vmcnt(0)" ::: "memory");
        } else {
            XB_SPIN(xb_ld(&bar[XB_XGEN(b.x)]) == gen, bar);
            __builtin_amdgcn_fence(__ATOMIC_ACQUIRE, "agent");
            asm volatile("s_waitcnt vmcnt(0)" ::: "memory");
        }
    } }
    __syncthreads();
}

__device__ __forceinline__ void panel_barrier(unsigned* cnt, unsigned round, unsigned* tmo_bar, int wv) {
    asm volatile("s_waitcnt vmcnt(0)" ::: "memory");
    __syncthreads();
    if (opaque_int(wv) == 0) { if (lane_id() == 0) {
        unsigned* c = (unsigned*)opaque_ptr((unsigned char*)cnt);
        (void)xb_add(c, 1u);
        const unsigned want = 4u * round;
        XB_SPIN(xb_ld(c) < want, tmo_bar);
        __builtin_amdgcn_fence(__ATOMIC_ACQUIRE, "agent");
        asm volatile("s_waitcnt vmcnt(0)" ::: "memory");
    } }
    __syncthreads();
}

__global__ void __launch_bounds__(512, 2) fwd_kernel(Args a) {
    extern __shared__ __attribute__((aligned(16))) unsigned char lds_raw[];
    LAS unsigned char* lds = (LAS unsigned char*)lds_raw;
    const int G0 = gridDim.x, bid0 = blockIdx.x, wv = __builtin_amdgcn_readfirstlane(threadIdx.x >> 6);
    unsigned char* ws0 = a.ws; float* X = a.out;
    volatile LAS unsigned* bst = (volatile LAS unsigned*)(lds + LDS_BYTES - 64);
    if (threadIdx.x < 2) bst[threadIdx.x] = 0u;
    __syncthreads();
    XcdBarrier xbar; xbar.bar = (unsigned*)(ws0 + WS_BAR); xbar.x = 0; xbar.st = bst;
#define REP(bit) _Pragma("unroll 1") for (int rep_ = 0, nrep_ = opaque_int((DUP_MASK & (bit)) ? 2 : 1); rep_ < nrep_; ++rep_)
#define OPQ() unsigned char* ws = opaque_ptr(ws0); const int G = opaque_int(G0), bid = opaque_int(bid0); pg8::ss_t* SS = (pg8::ss_t*)(ws + WS_SS); bf16_t* XB = (bf16_t*)(ws + ((l & 1) ? WS_XB2 : WS_XB)); bf16_t* XBN = (bf16_t*)(ws + ((l & 1) ? WS_XB : WS_XB2)); bf16_t* R1 = (bf16_t*)(ws + WS_R1); \
        bf16_t* ACT = R1; bf16_t* Qb = R1; bf16_t* Kb = R1 + (size_t)M * D; bf16_t* Vb = R1 + (size_t)2 * M * D; bf16_t* Ob = R1 + (size_t)3 * M * D; bf16_t* Ub = R1; bf16_t* PLb = R1 + (size_t)M * D; bf16_t* PE = (bf16_t*)(ws + WS_PE); \
        (void)SS; (void)XB; (void)XBN; (void)ACT; (void)Qb; (void)Kb; (void)Vb; (void)Ob; (void)Ub; (void)PLb; (void)PE; (void)G; (void)bid
#define SEAM() xcd_barrier(xbar, wv)
#define GEMM_SEAM(first) do { pg8::gemm_prefetch_b(lds, g, S, wv); if (first) { asm volatile("s_waitcnt vmcnt(0)" ::: "memory"); __syncthreads(); } else SEAM(); } while (0)
    xbar = xcd_barrier_post((unsigned*)(ws0 + WS_BAR), bst);
    prologue(a, lds, G0);
    __syncthreads();
    if (a.ph_lo != 0) cg::this_grid().sync();
#pragma unroll 1
    for (int l = 0; l < DEPTH; ++l) {
        const int j = l >> 1; const bool is_attn = (l & 1) == 0;
        pg8::StaticOrder S;
#pragma unroll 1
        for (int f = 0; f < 2; ++f) {
            {
                OPQ();
                pg8::Gemm g{XB, (const bf16_t*)(ws + WS_WGU + (size_t)(2 * l + f) * SZ_WGU), D, D, D, 0, 0, 1}; S.init(M, 2 * DFF, G, bid);
                pg8::EpiGU E{SS + (size_t)(4 * l + 2 * f) * M, ACT};
                GEMM_SEAM(false);
                pg8::gemm_phase<pg8::EpiGU, true, true>(lds, g, S, E, wv);
                if (DUP_MASK & 8) { pg8::gemm_phase<pg8::EpiGU, true, false>(lds, g, S, E, wv); }
                if (DUP_MASK & 2048) { pg8::EpiNull EN; pg8::gemm_phase<pg8::EpiNull, true, false>(lds, g, S, EN, wv); }
                if (DUP_MASK & 4096) { pg8::EpiNull EN; pg8::Gemm gp = g; gp.umask = opaque_int(0); pg8::gemm_phase<pg8::EpiNull, true, false>(lds, gp, S, EN, wv); }
                if (f == 0 && G == 256 && bid >= 128) {
                    const int tid2 = wv * 64 + lane_id(), sb = bid - 128;
                    const f32x4* p4 = (const f32x4*)(a.in[1] + (size_t)l * M * PLE); u32x4* pb = (u32x4*)(ws + WS_PB + (size_t)l * M * PLE * 2); const int n8 = M * PLE / 8;
                    for (int i = sb * 512 + tid2; i < n8; i += 128 * 512) { const f32x4 v0 = p4[2 * i], v1 = p4[2 * i + 1]; u32x4 w; w.x = pk2(v0[0], v0[1]); w.y = pk2(v0[2], v0[3]); w.z = pk2(v1[0], v1[1]); w.w = pk2(v1[2], v1[3]); pb[i] = w; }
                }
                if (f == 1 && G == 256 && bid >= 128) {
                    pg8::Gemm g2{(const bf16_t*)(ws + WS_PB) + (size_t)l * M * PLE, (const bf16_t*)(ws + WS_WPROJ + (size_t)l * SZ_WPROJ), PLE, PLE, PLE, 0, 0, 1}; pg8::StaticOrder S2; S2.init(M, D, 128, bid - 128);
                    pg8::EpiBf16S<false> E2{nullptr, PE, D};
                    pg8::gemm_phase<pg8::EpiBf16S<false>, false, false>(lds, g2, S2, E2, wv);
                }
            }
            {
                OPQ();
                pg8::Gemm g{ACT, (const bf16_t*)(ws + WS_WDN + (size_t)(2 * l + f) * SZ_WDN), DFF, DFF, DFF, 0, 0, 1}; S.init(M, D, G, bid);
                pg8::EpiRes<0> E{XB, XB, nullptr, SS + (size_t)(4 * l + 2 * f + 1) * M, 0.5f, nullptr, nullptr, nullptr};
                if (G == 256) { pg8::gemm_prefetch_b(lds, g, S, wv); panel_barrier((unsigned*)(ws + WS_BAR + 16384) + 64 * (8 * (bid & 7) + ((bid >> 3) & 7)), (unsigned)(2 * l + f + 1), xbar.bar, wv); }
                else GEMM_SEAM(false);
                pg8::gemm_phase<pg8::EpiRes<0>, false, true>(lds, g, S, E, wv);
            }
            if (f == 0) {
                if (is_attn) {
                    { OPQ();
                      pg8::Gemm g{XB, (const bf16_t*)(ws + WS_WQKV + (size_t)j * SZ_WQKV), D, D, D, 0, 0, 1}; S.init(M, 3 * D, G, bid);
                      pg8::EpiQKV E{SS + (size_t)(4 * l + 1) * M, Qb, a.in[7] + j * HD, a.in[8] + j * HD};
                      GEMM_SEAM(false);
                      pg8::gemm_phase<pg8::EpiQKV, true, true>(lds, g, S, E, wv); }
                    SEAM();
                    { OPQ(); REP(4) attn_phase(lds, Qb, Kb, Vb, Ob, G, wv); }
                    { OPQ();
                      pg8::Gemm g{Ob, (const bf16_t*)(ws + WS_WO + (size_t)j * SZ_WDD), D, D, D, 0, 0, 1}; S.init(M, D, G, bid);
                      pg8::EpiRes<0> E{XB, XB, nullptr, SS + (size_t)(4 * l + 2) * M, 1.0f, nullptr, nullptr, nullptr};
                      GEMM_SEAM(false);
                      pg8::gemm_phase<pg8::EpiRes<0>, false, true>(lds, g, S, E, wv); }
                } else {
                    { OPQ();
                      pg8::Gemm g{XB, (const bf16_t*)(ws + WS_WIN + (size_t)j * SZ_WDD), D, D, D, 0, 0, 1}; S.init(M, D, G, bid);
                      pg8::EpiBf16S<true> E{SS + (size_t)(4 * l + 1) * M, Ub, D};
                      GEMM_SEAM(false);
                      pg8::gemm_phase<pg8::EpiBf16S<true>, false, true>(lds, g, S, E, wv); }
                    { OPQ();
                      pg8::Gemm g{PLb, (const bf16_t*)(ws + WS_WGRP + (size_t)j * SZ_WGRP), D, 256, 256, 256, 0, 1}; S.init(M, D, G, bid);
                      pg8::EpiRes<1> E{XB, XB, nullptr, SS + (size_t)(4 * l + 2) * M, 1.0f, a.in[12] + j * D, nullptr, nullptr};
                      GEMM_SEAM(false);
                      { pg8::Unit pu; for (int i = 0; S.next(i, pu); ++i) pool_unit(Ub, PLb, pu.pm, pu.pn, wv); }
                      asm volatile("s_waitcnt vmcnt(0)" ::: "memory"); __syncthreads();
                      pg8::gemm_phase<pg8::EpiRes<1>, false, true>(lds, g, S, E, wv); }
                }
            }
        }
        {
            OPQ();
            if (G != 256) { SEAM();
              pg8::Gemm g{(const bf16_t*)(ws + WS_PB) + (size_t)l * M * PLE, (const bf16_t*)(ws + WS_WPROJ + (size_t)l * SZ_WPROJ), PLE, PLE, PLE, 0, 0, 1}; S.init(M, D, G, bid);
              pg8::EpiBf16S<false> E{nullptr, PE, D};
              pg8::gemm_phase<pg8::EpiBf16S<false>, false, false>(lds, g, S, E, wv); }
            pg8::Gemm g{XB, (const bf16_t*)(ws + WS_WGATE + (size_t)l * SZ_WDD), D, D, D, 0, 0, 1}; S.init(M, D, G, bid);
            GEMM_SEAM(false);
            if (l == DEPTH - 1) { pg8::EpiRes<3> E{XB, nullptr, X, nullptr, 1.0f, nullptr, SS + (size_t)(4 * l + 3) * M, PE}; pg8::gemm_phase<pg8::EpiRes<3>, false, true>(lds, g, S, E, wv); }
            else { pg8::EpiRes<2> E{XB, XBN, nullptr, SS + (size_t)(4 * l + 4) * M, 1.0f, nullptr, SS + (size_t)(4 * l + 3) * M, PE}; pg8::gemm_phase<pg8::EpiRes<2>, false, true>(lds, g, S, E, wv); }
        }
    }
#undef OPQ
#undef SEAM
#undef GEMM_SEAM
}

extern "C" void kernel_launch(void* const* d_in, const int* in_sizes, int n_in, void* d_out, int out_size, void* d_ws, size_t ws_size, hipStream_t stream) {
    static int grid = 0;
    if (grid == 0) {
        if (n_in != 19 || out_size != M * D || ws_size < WS_END) { fprintf(stderr, "kernel_launch: unexpected shapes (n_in %d, out %d, ws %zu, need %zu)\n", n_in, out_size, ws_size, (size_t)WS_END); grid = -1; return; }
        int dev = 0, cus = 0, per_cu = 0;
        hipGetDevice(&dev); hipDeviceGetAttribute(&cus, hipDeviceAttributeMultiprocessorCount, dev);
        if (hipFuncSetAttribute((const void*)fwd_kernel, hipFuncAttributeMaxDynamicSharedMemorySize, LDS_BYTES) != hipSuccess) { fprintf(stderr, "kernel_launch: hipFuncSetAttribute failed\n"); }
        if (hipOccupancyMaxActiveBlocksPerMultiprocessor(&per_cu, (const void*)fwd_kernel, 512, LDS_BYTES) != hipSuccess || per_cu < 1) per_cu = 1;
        (void)hipGetLastError();
        grid = cus * per_cu;
        fprintf(stderr, "kernel_launch: grid %d (cus %d x %d)\n", grid, cus, per_cu);
    }
    if (grid < 0) return;
    Args a{};
    for (int i = 0; i < 19; ++i) a.in[i] = (const float*)d_in[i];
    a.out = (float*)d_out; a.ws = (unsigned char*)d_ws;
    a.ph_lo = 0; a.ph_hi = NPHASE;
    if (hipMemsetAsync((char*)d_ws + WS_BAR, 0, 32768, stream) != hipSuccess) { fprintf(stderr, "kernel_launch: hipMemsetAsync of the barrier words failed\n"); return; }
    void* args[] = {&a};
    hipError_t e = hipLaunchCooperativeKernel((const void*)fwd_kernel, dim3(grid), dim3(512), args, LDS_BYTES, stream);
    if (e != hipSuccess) fprintf(stderr, "cooperative launch failed: %s (grid %d)\n", hipGetErrorString(e), grid);
}
```
